# Optimizing an MI355X kernel written in HIP

```python
import math
import jax, jax.numpy as jnp
from jax import lax
import numpy as np

D_MODEL = 1024
BATCH = 8
SEQ = 2048
DEPTH = 1

D_MIX = D_MODEL
D_RWKV = D_MIX // 2
RWKV_HEAD = 64
N_RWKV_HEADS = D_RWKV // RWKV_HEAD
D_ATT = D_MIX - D_RWKV
ATT_HEAD = 64
N_ATT_HEADS = D_ATT // ATT_HEAD
RANK_DECAY = 64
RANK_A = 64
RANK_GATE = 128
RWKV_GN_EPS = 64e-5
Q_LORA = D_MODEL // 4
KV_LORA = D_MODEL // 8
IDX_HEADS = 8
IDX_DIM = 64
TOPK_MAX = 256
Q_BLOCK = 128
N_EXPERTS = 32
TOP_K_EXPERTS = 4
D_FF = D_MODEL
SWIGLU_LIMIT = 7.0
SWIGLU_ALPHA = 1.702
MOE_BLOCK = 128
NEG_INF = -1e30

SPLIT_SHIFT = (D_RWKV, D_RWKV, D_RWKV, RANK_DECAY, RANK_A, RANK_GATE)
SPLIT_ATT = (Q_LORA, KV_LORA, IDX_DIM, IDX_HEADS)
N_SHIFT = sum(SPLIT_SHIFT)
N_IN = N_SHIFT + sum(SPLIT_ATT)

kernel_name = "hymba_rwkv7_dsa_moe_deepnorm_adaln"


def _split(z, sizes):
    idx = list(np.cumsum(sizes)[:-1])
    return jnp.split(z, idx, axis=-1)


def _layernorm(x, g, b, eps=1e-5):
    xf = x.astype(jnp.float32)
    mu = jnp.mean(xf, axis=-1, keepdims=True)
    var = jnp.mean(jnp.square(xf - mu), axis=-1, keepdims=True)
    return ((xf - mu) * lax.rsqrt(var + eps)).astype(x.dtype) * g + b


def _rmsnorm(x, g, eps=1e-6):
    xf = x.astype(jnp.float32)
    ms = jnp.mean(jnp.square(xf), axis=-1, keepdims=True)
    return (xf * lax.rsqrt(ms + eps)).astype(x.dtype) * g


def _alibi_slopes(n_heads):
    return jnp.asarray([2.0 ** (-8.0 * (h + 1) / n_heads) for h in range(n_heads)], jnp.float32)


def _rwkv7_scan(r, w, k, v, a, b):
    B, _, H, N = r.shape

    def step(state, inp):
        r_t, w_t, k_t, v_t, a_t, b_t = inp
        sa = jnp.einsum('bhvk,bhk->bhv', state, a_t)
        state = (state * w_t[:, :, None, :] + sa[..., None] * b_t[:, :, None, :]
                 + v_t[..., None] * k_t[:, :, None, :])
        return state, jnp.einsum('bhvk,bhk->bhv', state, r_t)

    xs = tuple(jnp.moveaxis(z, 1, 0) for z in (r, w, k, v, a, b))
    s0 = jnp.zeros((B, H, N, N), jnp.float32)
    _, o = lax.scan(step, s0, xs)
    return jnp.moveaxis(o, 0, 1)


def _rwkv7_group(pr, pk, pv, pw, pa, pg, w0, w2, a0, a2, g2, k_k, k_a, r_k, ln_w, ln_b):
    B, S, _ = pr.shape
    H, N = N_RWKV_HEADS, RWKV_HEAD
    f32 = jnp.float32
    w_log = -jax.nn.softplus(-(w0 + jnp.tanh(pw) @ w2).astype(f32)) - 0.5
    decay = jnp.exp(-jnp.exp(w_log))
    a = jax.nn.sigmoid((a0 + pa @ a2).astype(f32))
    g = jax.nn.sigmoid(pg) @ g2
    kk = (pk * k_k).astype(f32).reshape(B, S, H, N)
    kk = kk / jnp.maximum(jnp.sqrt(jnp.sum(kk * kk, axis=-1, keepdims=True)), 1e-12)
    k = (pk.astype(f32) * (1.0 + (a - 1.0) * k_a)).reshape(B, S, H, N)
    r = pr.astype(f32).reshape(B, S, H, N)
    v = pv.astype(f32).reshape(B, S, H, N)
    a_h = a.reshape(B, S, H, N)
    o = _rwkv7_scan(r, decay.reshape(B, S, H, N), k, v, -kk, kk * a_h)
    mu = jnp.mean(o, axis=-1, keepdims=True)
    var = jnp.mean(jnp.square(o - mu), axis=-1, keepdims=True)
    o = ((o - mu) * lax.rsqrt(var + RWKV_GN_EPS)).reshape(B, S, D_RWKV) * ln_w + ln_b
    bonus = jnp.sum(r * k * r_k, axis=-1, keepdims=True) * v
    o = (o + bonus.reshape(B, S, D_RWKV)) * g
    return o.astype(pr.dtype)


def _dsa_sparse_attention(q_abs, iq, iw, k_idx, c_lat, topk):
    B, S, H, C = q_abs.shape
    nb = S // Q_BLOCK
    f32 = jnp.float32
    slopes = _alibi_slopes(H)
    spos = jnp.arange(S, dtype=jnp.int32)
    tpos = spos.reshape(nb, Q_BLOCK)
    k_idx_f = k_idx.astype(f32)
    c_f = c_lat.astype(f32)
    idx_scale = IDX_DIM ** -0.5
    att_scale = ATT_HEAD ** -0.5
    gather = jax.vmap(lambda cb, ib: cb[ib])

    def blk(z):
        return jnp.moveaxis(z.reshape((B, nb, Q_BLOCK) + z.shape[2:]), 1, 0)

    def one_block(args):
        qa, iqb, iwb, tp = args
        s_idx = jnp.einsum('bqhd,bsd->bqhs', iqb.astype(f32), k_idx_f) * idx_scale
        score = jnp.einsum('bqh,bqhs->bqs', iwb.astype(f32), jax.nn.relu(s_idx))
        causal = spos[None, :] <= tp[:, None]
        score = jnp.where(causal[None], score, NEG_INF)
        _, sel = lax.top_k(score, topk)
        c_sel = gather(c_f, sel)
        logits = jnp.einsum('bqhc,bqkc->bqhk', qa.astype(f32), c_sel) * att_scale
        dist = tp[None, :, None] - sel
        logits = logits - slopes[None, None, :, None] * dist.astype(f32)[:, :, None, :]
        logits = jnp.where((dist >= 0)[:, :, None, :], logits, NEG_INF)
        p = jax.nn.softmax(logits, axis=-1)
        return jnp.einsum('bqhk,bqkc->bqhc', p, c_sel)

    o_lat = lax.map(one_block, (blk(q_abs), blk(iq), blk(iw), tpos))
    return jnp.moveaxis(o_lat, 0, 1).reshape(B, S, H, C).astype(q_abs.dtype)


def _dsa_group(pq, pkv, pik, piw, q_norm, w_q_up, kv_norm, w_uk, w_uv, idx_w_q, idx_ln_g, idx_ln_b):
    B, S, _ = pq.shape
    topk = min(TOPK_MAX, S // 4)
    q_lat = _rmsnorm(pq, q_norm)
    q = (q_lat @ w_q_up).reshape(B, S, N_ATT_HEADS, ATT_HEAD)
    q_abs = jnp.einsum('bshd,hdc->bshc', q, w_uk)
    c_lat = _rmsnorm(pkv, kv_norm)
    iq = (q_lat @ idx_w_q).reshape(B, S, IDX_HEADS, IDX_DIM)
    ik = _layernorm(pik, idx_ln_g, idx_ln_b)
    iw = piw * (IDX_HEADS ** -0.5)
    o_lat = _dsa_sparse_attention(q_abs, iq, iw, ik, c_lat, topk)
    o = jnp.einsum('bshc,hcd->bshd', o_lat, w_uv)
    return o.reshape(B, S, D_ATT)


def _moe(u, w_router, b_router, w_gu, b_gu, w_dn, b_dn):
    B, S, D = u.shape
    T = B * S
    TK = T * TOP_K_EXPERTS
    xt = u.reshape(T, D)
    logits = (xt @ w_router + b_router).astype(jnp.float32)
    top_val, top_idx = lax.top_k(logits, TOP_K_EXPERTS)
    gates = jax.nn.softmax(top_val, axis=-1)
    flat_e = top_idx.reshape(-1)
    flat_tok = jnp.repeat(jnp.arange(T, dtype=jnp.int32), TOP_K_EXPERTS)
    flat_g = gates.reshape(-1)
    order = jnp.argsort(flat_e)
    e_sorted = flat_e[order]
    counts = jnp.bincount(flat_e, length=N_EXPERTS)
    starts = jnp.cumsum(counts) - counts
    padded = (counts + MOE_BLOCK - 1) // MOE_BLOCK * MOE_BLOCK
    pad_ends = jnp.cumsum(padded)
    pad_starts = pad_ends - padded
    dest = pad_starts[e_sorted] + (jnp.arange(TK, dtype=jnp.int32) - starts[e_sorted])
    n_blocks = -(-TK // MOE_BLOCK) + N_EXPERTS
    n_rows = n_blocks * MOE_BLOCK
    row_tok = jnp.zeros((n_rows,), jnp.int32).at[dest].set(flat_tok[order])
    row_gate = jnp.zeros((n_rows,), jnp.float32).at[dest].set(flat_g[order])
    block_e = jnp.minimum(jnp.searchsorted(pad_ends, jnp.arange(n_blocks) * MOE_BLOCK, side='right'),
                          N_EXPERTS - 1).astype(jnp.int32)

    def expert_block(args):
        e, tok = args
        xb = xt[tok]
        gu = xb @ w_gu[e] + b_gu[e]
        gate = jnp.minimum(gu[:, 0::2], SWIGLU_LIMIT)
        up = jnp.clip(gu[:, 1::2], -SWIGLU_LIMIT, SWIGLU_LIMIT)
        h = (up + 1.0) * (gate * jax.nn.sigmoid(gate * SWIGLU_ALPHA))
        return h @ w_dn[e] + b_dn[e]

    out = lax.map(expert_block, (block_e, row_tok.reshape(n_blocks, MOE_BLOCK)))
    out = out.reshape(n_rows, D).astype(jnp.float32) * row_gate[:, None]
    y = jnp.zeros((T, D), jnp.float32).at[row_tok].add(out)
    return y.reshape(B, S, D).astype(u.dtype)


def setup_inputs(seed: int = 0) -> dict:
    key = jax.random.key(seed)
    ks = iter(jax.random.split(key, 40))
    L = DEPTH
    beta = (8.0 * DEPTH) ** -0.25

    def nrm(shape, scale):
        return jax.random.normal(next(ks), shape, jnp.float32) * scale

    d = D_MODEL
    inp = {}
    inp['x'] = nrm((BATCH, SEQ, d), 1.0)
    inp['c'] = nrm((BATCH, d), 1.0)
    inp['w_ada'] = nrm((L, d, 6 * d), 0.5 * d ** -0.5)
    inp['b_ada'] = nrm((L, 6 * d), 0.01)
    inp['w_in'] = nrm((L, d, N_IN), d ** -0.5)
    inp['shift_mu'] = jax.random.uniform(next(ks), (L, N_SHIFT), jnp.float32)
    inp['rwkv_w0'] = jax.random.uniform(next(ks), (L, D_RWKV), jnp.float32, -6.0, -1.0)
    inp['rwkv_w2'] = nrm((L, RANK_DECAY, D_RWKV), 0.5 * RANK_DECAY ** -0.5)
    inp['rwkv_a0'] = nrm((L, D_RWKV), 0.1)
    inp['rwkv_a2'] = nrm((L, RANK_A, D_RWKV), RANK_A ** -0.5)
    inp['rwkv_g2'] = nrm((L, RANK_GATE, D_RWKV), RANK_GATE ** -0.5)
    inp['rwkv_k_k'] = 0.85 + nrm((L, D_RWKV), 0.05)
    inp['rwkv_k_a'] = 1.0 + nrm((L, D_RWKV), 0.05)
    inp['rwkv_r_k'] = nrm((L, N_RWKV_HEADS, RWKV_HEAD), 0.1)
    inp['rwkv_ln_w'] = 1.0 + nrm((L, D_RWKV), 0.05)
    inp['rwkv_ln_b'] = nrm((L, D_RWKV), 0.01)
    inp['mla_q_norm'] = 1.0 + nrm((L, Q_LORA), 0.05)
    inp['mla_w_q_up'] = nrm((L, Q_LORA, N_ATT_HEADS * ATT_HEAD), Q_LORA ** -0.5)
    inp['mla_kv_norm'] = 1.0 + nrm((L, KV_LORA), 0.05)
    inp['mla_w_uk'] = nrm((L, N_ATT_HEADS, ATT_HEAD, KV_LORA), ATT_HEAD ** -0.5)
    inp['mla_w_uv'] = nrm((L, N_ATT_HEADS, KV_LORA, ATT_HEAD), KV_LORA ** -0.5)
    inp['idx_w_q'] = nrm((L, Q_LORA, IDX_HEADS * IDX_DIM), Q_LORA ** -0.5)
    inp['idx_ln_g'] = 1.0 + nrm((L, IDX_DIM), 0.05)
    inp['idx_ln_b'] = nrm((L, IDX_DIM), 0.01)
    inp['w_out'] = nrm((L, D_MIX, d), beta * D_MIX ** -0.5)
    inp['ln1_g'] = 1.0 + nrm((L, d), 0.05)
    inp['ln1_b'] = nrm((L, d), 0.01)
    inp['w_router'] = nrm((L, d, N_EXPERTS), d ** -0.5)
    inp['b_router'] = nrm((L, N_EXPERTS), 0.01)
    inp['w_gu'] = nrm((L, N_EXPERTS, d, 2 * D_FF), d ** -0.5)
    inp['b_gu'] = nrm((L, N_EXPERTS, 2 * D_FF), 0.01)
    inp['w_dn'] = nrm((L, N_EXPERTS, D_FF, d), beta * D_FF ** -0.5)
    inp['b_dn'] = nrm((L, N_EXPERTS, d), 0.01)
    inp['ln2_g'] = 1.0 + nrm((L, d), 0.05)
    inp['ln2_b'] = nrm((L, d), 0.01)
    return inp


def reference(x, c, w_ada, b_ada, w_in, shift_mu, rwkv_w0, rwkv_w2, rwkv_a0, rwkv_a2, rwkv_g2,
              rwkv_k_k, rwkv_k_a, rwkv_r_k, rwkv_ln_w, rwkv_ln_b, mla_q_norm, mla_w_q_up,
              mla_kv_norm, mla_w_uk, mla_w_uv, idx_w_q, idx_ln_g, idx_ln_b, w_out, ln1_g, ln1_b,
              w_router, b_router, w_gu, b_gu, w_dn, b_dn, ln2_g, ln2_b):
    alpha = (2.0 * DEPTH) ** 0.25
    c_act = jax.nn.silu(c)
    for l in range(DEPTH):
        mod = c_act @ w_ada[l] + b_ada[l]
        sh1, sc1, gt1, sh2, sc2, gt2 = [m[:, None, :] for m in jnp.split(mod, 6, axis=-1)]

        u = x * (1.0 + sc1) + sh1
        p = u @ w_in[l]
        p_sh = p[..., :N_SHIFT]
        p_prev = jnp.pad(p_sh[:, :-1], ((0, 0), (1, 0), (0, 0)))
        p_sh = p_sh + shift_mu[l] * (p_prev - p_sh)
        pr, pk, pv, pw, pa, pg = _split(p_sh, SPLIT_SHIFT)
        pq, pkv, pik, piw = _split(p[..., N_SHIFT:], SPLIT_ATT)
        o_rwkv = _rwkv7_group(pr, pk, pv, pw, pa, pg, rwkv_w0[l], rwkv_w2[l], rwkv_a0[l], rwkv_a2[l],
                              rwkv_g2[l], rwkv_k_k[l], rwkv_k_a[l], rwkv_r_k[l], rwkv_ln_w[l], rwkv_ln_b[l])
        o_dsa = _dsa_group(pq, pkv, pik, piw, mla_q_norm[l], mla_w_q_up[l], mla_kv_norm[l], mla_w_uk[l],
                           mla_w_uv[l], idx_w_q[l], idx_ln_g[l], idx_ln_b[l])
        mix = jnp.concatenate([o_rwkv, o_dsa], axis=-1) @ w_out[l]
        x = _layernorm(alpha * x + (1.0 + gt1) * mix, ln1_g[l], ln1_b[l])

        u = x * (1.0 + sc2) + sh2
        ffn = _moe(u, w_router[l], b_router[l], w_gu[l], b_gu[l], w_dn[l], b_dn[l])
        x = _layernorm(alpha * x + (1.0 + gt2) * ffn, ln2_g[l], ln2_b[l])
    return x
```

```cpp
#include <hip/hip_runtime.h>
#include <stdint.h>

#define T_TOK 16384
#define SEQ 2048
#define NBATCH 8
#define DM 1024
#define N_IN 2248
#define N_SHIFT 1792
#define NTHR 256

struct Params {
  const float *x, *c, *w_ada, *b_ada, *w_in, *shift_mu, *w0, *w2, *a0, *a2, *g2, *k_k, *k_a, *r_k, *ln_w, *ln_b,
      *q_norm, *w_q_up, *kv_norm, *w_uk, *w_uv, *idx_w_q, *idx_ln_g, *idx_ln_b, *w_out, *ln1_g, *ln1_b, *w_router,
      *b_router, *w_gu, *b_gu, *w_dn, *b_dn, *ln2_g, *ln2_b;
  float* out;
  float *mod, *P, *SC, *G, *BV, *QLAT, *CLAT, *IK, *IW, *Q, *IQ, *QABS, *SCORES, *ORAW, *OCAT, *OLAT, *Y1, *X1, *H, *PO,
      *pgate;
  int *SEL, *NSEL, *lists, *cnt;
};

__device__ __forceinline__ float sigmoidf_(float v) { return 1.0f / (1.0f + expf(-v)); }

__device__ __forceinline__ float wave_sum(float v) {
#pragma unroll
  for (int o = 32; o > 0; o >>= 1) v += __shfl_xor(v, o, 64);
  return v;
}
__device__ __forceinline__ float wave_max(float v) {
#pragma unroll
  for (int o = 32; o > 0; o >>= 1) v = fmaxf(v, __shfl_xor(v, o, 64));
  return v;
}
__device__ __forceinline__ int wave_sum_i(int v) {
#pragma unroll
  for (int o = 32; o > 0; o >>= 1) v += __shfl_xor(v, o, 64);
  return v;
}

#define GSTR 68
template <bool BT, class AL, class BL>
__device__ __forceinline__ void gemm_core(int K, const AL& aload, const BL& bload, float (&acc)[4][4], float* sm) {
  float* As = sm;
  float* Bs = sm + 16 * GSTR;
  const int tid = threadIdx.x;
  const int ar = tid >> 2, ak = (tid & 3) * 4;
  const int bk = tid >> 4, bn = (tid & 15) * 4;
  const int ty = tid >> 4, tx = tid & 15;
#pragma unroll
  for (int i = 0; i < 4; ++i)
#pragma unroll
    for (int j = 0; j < 4; ++j) acc[i][j] = 0.f;
  float4 av = aload(ar, ak);
  float4 bv = BT ? bload(ar, ak) : bload(bk, bn);
  for (int k0 = 0; k0 < K; k0 += 16) {
    __syncthreads();
    As[(ak + 0) * GSTR + ar] = av.x;
    As[(ak + 1) * GSTR + ar] = av.y;
    As[(ak + 2) * GSTR + ar] = av.z;
    As[(ak + 3) * GSTR + ar] = av.w;
    if (BT) {
      Bs[(ak + 0) * GSTR + ar] = bv.x;
      Bs[(ak + 1) * GSTR + ar] = bv.y;
      Bs[(ak + 2) * GSTR + ar] = bv.z;
      Bs[(ak + 3) * GSTR + ar] = bv.w;
    } else {
      *(float4*)&Bs[bk * GSTR + bn] = bv;
    }
    __syncthreads();
    if (k0 + 16 < K) {
      av = aload(ar, k0 + 16 + ak);
      bv = BT ? bload(ar, k0 + 16 + ak) : bload(k0 + 16 + bk, bn);
    }
#pragma unroll
    for (int k = 0; k < 16; ++k) {
      const float4 a = *(const float4*)&As[k * GSTR + ty * 4];
      const float4 b = *(const float4*)&Bs[k * GSTR + tx * 4];
      acc[0][0] += a.x * b.x; acc[0][1] += a.x * b.y; acc[0][2] += a.x * b.z; acc[0][3] += a.x * b.w;
      acc[1][0] += a.y * b.x; acc[1][1] += a.y * b.y; acc[1][2] += a.y * b.z; acc[1][3] += a.y * b.w;
      acc[2][0] += a.z * b.x; acc[2][1] += a.z * b.y; acc[2][2] += a.z * b.z; acc[2][3] += a.z * b.w;
      acc[3][0] += a.w * b.x; acc[3][1] += a.w * b.y; acc[3][2] += a.w * b.z; acc[3][3] += a.w * b.w;
    }
  }
}
#define GEMM_SM (2 * 16 * GSTR)

__device__ void phase_ada(const Params& p, int bid, int nb, float* sm) {
  const int tid = threadIdx.x;
  float* cact = sm;
  float* red = sm + 8192;
  if (bid == 0 && tid < 32) p.cnt[tid] = 0;
  for (int i = tid; i < 8192; i += NTHR) {
    float v = p.c[i];
    cact[i] = v / (1.0f + expf(-v));
  }
  __syncthreads();
  for (int item = bid; item < 96; item += nb) {
    const int cl = tid & 63, kq = tid >> 6;
    const int col = item * 64 + cl;
    float acc[8];
#pragma unroll
    for (int b = 0; b < 8; ++b) acc[b] = 0.f;
    for (int k = kq * 256; k < kq * 256 + 256; ++k) {
      const float w = p.w_ada[(size_t)k * 6144 + col];
#pragma unroll
      for (int b = 0; b < 8; ++b) acc[b] += cact[b * 1024 + k] * w;
    }
#pragma unroll
    for (int b = 0; b < 8; ++b) red[(kq * 8 + b) * 64 + cl] = acc[b];
    __syncthreads();
    for (int o = tid; o < 512; o += NTHR) {
      const int b = o >> 6, cc = o & 63;
      const float s = red[(0 * 8 + b) * 64 + cc] + red[(1 * 8 + b) * 64 + cc] + red[(2 * 8 + b) * 64 + cc] +
                      red[(3 * 8 + b) * 64 + cc];
      p.mod[b * 6144 + item * 64 + cc] = s + p.b_ada[item * 64 + cc];
    }
    __syncthreads();
  }
}

__device__ void phase_win(const Params& p, int bid, int nb, float* sm) {
  const int tid = threadIdx.x, ty = tid >> 4, tx = tid & 15;
  for (int item = bid; item < 256 * 36; item += nb) {
    const int nt = item % 36, mt = item / 36;
    const int bb = (mt * 64) >> 11;
    const float* modb = p.mod + bb * 6144;
    auto aload = [&](int r, int k) -> float4 {
      const float4 xv = *(const float4*)&p.x[(size_t)(mt * 64 + r) * DM + k];
      const float4 sc = *(const float4*)&modb[1024 + k];
      const float4 sh = *(const float4*)&modb[k];
      return make_float4(xv.x * (1.f + sc.x) + sh.x, xv.y * (1.f + sc.y) + sh.y, xv.z * (1.f + sc.z) + sh.z,
                         xv.w * (1.f + sc.w) + sh.w);
    };
    auto bload = [&](int k, int n) -> float4 {
      const int col = nt * 64 + n;
      if (col < N_IN) return *(const float4*)&p.w_in[(size_t)k * N_IN + col];
      return make_float4(0.f, 0.f, 0.f, 0.f);
    };
    float acc[4][4];
    gemm_core<false>(DM, aload, bload, acc, sm);
#pragma unroll
    for (int i = 0; i < 4; ++i) {
      const int t = mt * 64 + ty * 4 + i;
      const int col = nt * 64 + tx * 4;
      if (col < N_IN) *(float4*)&p.P[(size_t)t * N_IN + col] = make_float4(acc[i][0], acc[i][1], acc[i][2], acc[i][3]);
    }
  }
}

__device__ __forceinline__ float psh(const Params& p, int t, int s, int j) {
  const float cur = p.P[(size_t)t * N_IN + j];
  const float mu = p.shift_mu[j];
  const float prev = (s == 0) ? 0.f : p.P[(size_t)(t - 1) * N_IN + j];
  return cur + mu * (prev - cur);
}

__device__ void phase_prep_rwkv(const Params& p, int bid, int nb, float* sm) {
  const int tid = threadIdx.x, lane = tid & 63;
  float* actw = sm;
  float* acta = sm + 512;
  float* actg = sm + 1024;
  for (int item = bid; item < T_TOK / 8; item += nb) {
    const int t0 = item * 8;
    __syncthreads();
    for (int i = tid; i < 8 * 256; i += NTHR) {
      const int tk = i >> 8, jj = i & 255;
      const int t = t0 + tk, s = t & (SEQ - 1);
      const float v = psh(p, t, s, 1536 + jj);
      if (jj < 64) actw[tk * 64 + jj] = tanhf(v);
      else if (jj < 128) acta[tk * 64 + (jj - 64)] = v;
      else actg[tk * 128 + (jj - 128)] = sigmoidf_(v);
    }
    __syncthreads();
    for (int half = 0; half < 2; ++half) {
      const int c = tid + half * 256;
      const int h = c >> 6, n = c & 63;
      float wacc[8], aacc[8], gacc[8];
#pragma unroll
      for (int i = 0; i < 8; ++i) { wacc[i] = 0.f; aacc[i] = 0.f; gacc[i] = 0.f; }
      for (int j = 0; j < 64; ++j) {
        const float w2v = p.w2[j * 512 + c], a2v = p.a2[j * 512 + c];
#pragma unroll
        for (int i = 0; i < 8; ++i) { wacc[i] += actw[i * 64 + j] * w2v; aacc[i] += acta[i * 64 + j] * a2v; }
      }
      for (int j = 0; j < 128; ++j) {
        const float g2v = p.g2[j * 512 + c];
#pragma unroll
        for (int i = 0; i < 8; ++i) gacc[i] += actg[i * 128 + j] * g2v;
      }
      const float w0v = p.w0[c], a0v = p.a0[c], kkv = p.k_k[c], kav = p.k_a[c], rkv = p.r_k[c];
#pragma unroll
      for (int i = 0; i < 8; ++i) {
        const int t = t0 + i, s = t & (SEQ - 1), b = t >> 11;
        const float pr = psh(p, t, s, c), pk = psh(p, t, s, 512 + c), pv = psh(p, t, s, 1024 + c);
        const float z = -(w0v + wacc[i]);
        const float sp = fmaxf(z, 0.f) + log1pf(expf(-fabsf(z)));
        const float wlog = -sp - 0.5f;
        const float decay = expf(-expf(wlog));
        const float a = sigmoidf_(a0v + aacc[i]);
        const float kkr = pk * kkv;
        const float ss = wave_sum(kkr * kkr);
        const float kk = kkr / fmaxf(sqrtf(ss), 1e-12f);
        const float k = pk * (1.f + (a - 1.f) * kav);
        const float bonus = wave_sum(pr * k * rkv);
        float* sc = p.SC + ((size_t)((b * 8 + h) * SEQ + s)) * 384;
        sc[0 * 64 + n] = decay;
        sc[1 * 64 + n] = -kk;
        sc[2 * 64 + n] = kk * a;
        sc[3 * 64 + n] = k;
        sc[4 * 64 + n] = pr;
        sc[5 * 64 + n] = pv;
        p.G[(size_t)t * 512 + c] = gacc[i];
        p.BV[(size_t)t * 512 + c] = bonus * pv;
      }
    }
  }
  (void)lane;
}

__device__ void phase_prep_dsa(const Params& p, int bid, int nb, float* sm) {
  const int tid = threadIdx.x, lane = tid & 63, wv = tid >> 6;
  for (int item = bid; item < T_TOK / 4; item += nb) {
    const int t = item * 4 + wv;
    const float* row = p.P + (size_t)t * N_IN;
    {
      const float4 v = *(const float4*)&row[1792 + lane * 4];
      const float ms = wave_sum(v.x * v.x + v.y * v.y + v.z * v.z + v.w * v.w) * (1.f / 256.f);
      const float rs = rsqrtf(ms + 1e-6f);
      const float4 g = *(const float4*)&p.q_norm[lane * 4];
      *(float4*)&p.QLAT[(size_t)t * 256 + lane * 4] = make_float4(v.x * rs * g.x, v.y * rs * g.y, v.z * rs * g.z, v.w * rs * g.w);
    }
    {
      const float2 v = *(const float2*)&row[2048 + lane * 2];
      const float ms = wave_sum(v.x * v.x + v.y * v.y) * (1.f / 128.f);
      const float rs = rsqrtf(ms + 1e-6f);
      const float2 g = *(const float2*)&p.kv_norm[lane * 2];
      *(float2*)&p.CLAT[(size_t)t * 128 + lane * 2] = make_float2(v.x * rs * g.x, v.y * rs * g.y);
    }
    {
      const float v = row[2176 + lane];
      const float mu = wave_sum(v) * (1.f / 64.f);
      const float d = v - mu;
      const float var = wave_sum(d * d) * (1.f / 64.f);
      p.IK[(size_t)t * 64 + lane] = d * rsqrtf(var + 1e-5f) * p.idx_ln_g[lane] + p.idx_ln_b[lane];
    }
    if (lane < 8) p.IW[(size_t)t * 8 + lane] = row[2240 + lane] * 0.35355339059327373f;
  }
  (void)sm;
}

__device__ void phase_qproj(const Params& p, int bid, int nb, float* sm) {
  const int tid = threadIdx.x, ty = tid >> 4, tx = tid & 15;
  for (int item = bid; item < 256 * 16; item += nb) {
    const int nt = item & 15, mt = item >> 4;
    const float* W = (nt < 8) ? p.w_q_up : p.idx_w_q;
    float* O = (nt < 8) ? p.Q : p.IQ;
    const int n0 = (nt & 7) * 64;
    auto aload = [&](int r, int k) -> float4 { return *(const float4*)&p.QLAT[(size_t)(mt * 64 + r) * 256 + k]; };
    auto bload = [&](int k, int n) -> float4 { return *(const float4*)&W[(size_t)k * 512 + n0 + n]; };
    float acc[4][4];
    gemm_core<false>(256, aload, bload, acc, sm);
#pragma unroll
    for (int i = 0; i < 4; ++i)
      *(float4*)&O[(size_t)(mt * 64 + ty * 4 + i) * 512 + n0 + tx * 4] = make_float4(acc[i][0], acc[i][1], acc[i][2], acc[i][3]);
  }
}

__device__ void phase_qabs(const Params& p, int bid, int nb, float* sm) {
  const int tid = threadIdx.x, ty = tid >> 4, tx = tid & 15;
  for (int item = bid; item < 256 * 16; item += nb) {
    const int nt = item & 15, mt = item >> 4;
    const int h = nt >> 1, c0 = (nt & 1) * 64;
    auto aload = [&](int r, int k) -> float4 { return *(const float4*)&p.Q[(size_t)(mt * 64 + r) * 512 + h * 64 + k]; };
    auto bload = [&](int k, int n) -> float4 { return *(const float4*)&p.w_uk[((size_t)h * 64 + k) * 128 + c0 + n]; };
    float acc[4][4];
    gemm_core<false>(64, aload, bload, acc, sm);
#pragma unroll
    for (int i = 0; i < 4; ++i)
      *(float4*)&p.QABS[(size_t)(mt * 64 + ty * 4 + i) * 1024 + h * 128 + c0 + tx * 4] =
          make_float4(acc[i][0], acc[i][1], acc[i][2], acc[i][3]);
  }
}

#define SCAN_TC 16
__device__ void phase_scan(const Params& p, int bid, int nb, float* sm) {
  const int tid = threadIdx.x, lane = tid & 63, wv = tid >> 6;
  float* buf = sm;
  float* obuf = sm + SCAN_TC * 384;
  const int l16 = lane & 15;
  const int rloc = wv * 4 + (lane >> 4);
  for (int item = bid; item < 256; item += nb) {
    const int bh = item >> 2, rg = item & 3;
    const int b = bh >> 3, h = bh & 7;
    const int row = rg * 16 + rloc;
    const float* src = p.SC + (size_t)bh * SEQ * 384;
    float s0 = 0.f, s1 = 0.f, s2 = 0.f, s3 = 0.f;
    for (int c0 = 0; c0 < SEQ; c0 += SCAN_TC) {
      __syncthreads();
      for (int i = tid; i < SCAN_TC * 384 / 4; i += NTHR)
        ((float4*)buf)[i] = ((const float4*)(src + (size_t)c0 * 384))[i];
      __syncthreads();
      for (int st = 0; st < SCAN_TC; ++st) {
        const float* q = buf + st * 384;
        const float4 w4 = *(const float4*)&q[0 * 64 + l16 * 4];
        const float4 a4 = *(const float4*)&q[1 * 64 + l16 * 4];
        const float4 b4 = *(const float4*)&q[2 * 64 + l16 * 4];
        const float4 k4 = *(const float4*)&q[3 * 64 + l16 * 4];
        const float4 r4 = *(const float4*)&q[4 * 64 + l16 * 4];
        const float vv = q[5 * 64 + row];
        float sa = s0 * a4.x + s1 * a4.y + s2 * a4.z + s3 * a4.w;
        sa += __shfl_xor(sa, 1, 64);
        sa += __shfl_xor(sa, 2, 64);
        sa += __shfl_xor(sa, 4, 64);
        sa += __shfl_xor(sa, 8, 64);
        s0 = s0 * w4.x + sa * b4.x + vv * k4.x;
        s1 = s1 * w4.y + sa * b4.y + vv * k4.y;
        s2 = s2 * w4.z + sa * b4.z + vv * k4.z;
        s3 = s3 * w4.w + sa * b4.w + vv * k4.w;
        float o = s0 * r4.x + s1 * r4.y + s2 * r4.z + s3 * r4.w;
        o += __shfl_xor(o, 1, 64);
        o += __shfl_xor(o, 2, 64);
        o += __shfl_xor(o, 4, 64);
        o += __shfl_xor(o, 8, 64);
        if (l16 == 0) obuf[st * 16 + rloc] = o;
      }
      __syncthreads();
      {
        const int st = tid >> 4, r = tid & 15;
        p.ORAW[(size_t)(b * SEQ + c0 + st) * 512 + h * 64 + rg * 16 + r] = obuf[st * 16 + r];
      }
    }
  }
}

__device__ void phase_rwkv_fin(const Params& p, int bid, int nb, float* sm) {
  const int tid = threadIdx.x, lane = tid & 63, wv = tid >> 6;
  for (int item = bid; item < T_TOK * 8 / 4; item += nb) {
    const int th = item * 4 + wv;
    const int t = th >> 3, h = th & 7;
    const int c = h * 64 + lane;
    const float o = p.ORAW[(size_t)t * 512 + c];
    const float mu = wave_sum(o) * (1.f / 64.f);
    const float d = o - mu;
    const float var = wave_sum(d * d) * (1.f / 64.f);
    const float v = (d * rsqrtf(var + 64e-5f) * p.ln_w[c] + p.ln_b[c] + p.BV[(size_t)t * 512 + c]) * p.G[(size_t)t * 512 + c];
    p.OCAT[(size_t)t * 1024 + c] = v;
  }
  (void)sm;
}

__device__ void phase_scores(const Params& p, int bid, int nb, float* sm) {
  const int tid = threadIdx.x, ty = tid >> 4, tx = tid & 15;
  for (int item = bid; item < 8 * 528; item += nb) {
    const int b = item / 528, pidx = item % 528;
    int tt = 0;
    while ((tt + 1) * (tt + 2) / 2 <= pidx) ++tt;
    const int st = pidx - tt * (tt + 1) / 2;
    float sc[4][4];
#pragma unroll
    for (int i = 0; i < 4; ++i)
#pragma unroll
      for (int j = 0; j < 4; ++j) sc[i][j] = 0.f;
    for (int h = 0; h < 8; ++h) {
      auto aload = [&](int r, int k) -> float4 {
        return *(const float4*)&p.IQ[(size_t)(b * SEQ + tt * 64 + r) * 512 + h * 64 + k];
      };
      auto bload = [&](int n, int k) -> float4 { return *(const float4*)&p.IK[(size_t)(b * SEQ + st * 64 + n) * 64 + k]; };
      float acc[4][4];
      gemm_core<true>(64, aload, bload, acc, sm);
#pragma unroll
      for (int i = 0; i < 4; ++i) {
        const float w = p.IW[(size_t)(b * SEQ + tt * 64 + ty * 4 + i) * 8 + h];
#pragma unroll
        for (int j = 0; j < 4; ++j) sc[i][j] += w * fmaxf(acc[i][j] * 0.125f, 0.f);
      }
    }
#pragma unroll
    for (int i = 0; i < 4; ++i) {
      const int t = tt * 64 + ty * 4 + i;
      *(float4*)&p.SCORES[((size_t)(b * SEQ + t)) * SEQ + st * 64 + tx * 4] = make_float4(sc[i][0], sc[i][1], sc[i][2], sc[i][3]);
    }
  }
}

__device__ __forceinline__ unsigned fkey(float f) {
  if (f == 0.f) f = 0.f;
  const unsigned u = __float_as_uint(f);
  return (u & 0x80000000u) ? ~u : (u | 0x80000000u);
}
__device__ void phase_topk(const Params& p, int bid, int nb, float* sm) {
  const int tid = threadIdx.x, lane = tid & 63, wv = tid >> 6;
  for (int item = bid; item < T_TOK / 4; item += nb) {
    const int q = item * 4 + wv;
    const int t = q & (SEQ - 1);
    int* sel = p.SEL + (size_t)q * 256;
    if (t < 256) {
      for (int j = lane; j <= t; j += 64) sel[j] = j;
      if (lane == 0) p.NSEL[q] = t + 1;
      continue;
    }
    const float* srow = p.SCORES + (size_t)q * SEQ;
    unsigned key[32];
#pragma unroll
    for (int i = 0; i < 32; ++i) {
      const int s = i * 64 + lane;
      key[i] = (s <= t) ? fkey(srow[s]) : 0u;
    }
    unsigned T = 0;
    for (int bit = 31; bit >= 0; --bit) {
      const unsigned cand = T | (1u << bit);
      int c = 0;
#pragma unroll
      for (int i = 0; i < 32; ++i) c += (key[i] >= cand) ? 1 : 0;
      c = wave_sum_i(c);
      if (c >= 256) T = cand;
    }
    int cgt = 0;
#pragma unroll
    for (int i = 0; i < 32; ++i) cgt += (key[i] > T) ? 1 : 0;
    cgt = wave_sum_i(cgt);
    const int need = 256 - cgt;
    int pos = 0, tie_seen = 0;
#pragma unroll
    for (int i = 0; i < 32; ++i) {
      const bool gt = key[i] > T;
      const bool eq = key[i] == T;
      const unsigned long long meq = __ballot(eq);
      const int eq_before = __popcll(meq & ((1ull << lane) - 1ull));
      const bool take = gt || (eq && (tie_seen + eq_before) < need);
      const unsigned long long mt = __ballot(take);
      const int before = __popcll(mt & ((1ull << lane) - 1ull));
      if (take) sel[pos + before] = i * 64 + lane;
      pos += __popcll(mt);
      tie_seen += __popcll(meq);
    }
    if (lane == 0) p.NSEL[q] = 256;
  }
  (void)sm;
}

__device__ void phase_attn(const Params& p, int bid, int nb, float* sm) {
  const int tid = threadIdx.x, lane = tid & 63, wv = tid >> 6;
  float* qs = sm;
  float* pl = sm + 1024;
  int* sl = (int*)(sm + 3072);
  for (int q = bid; q < T_TOK; q += nb) {
    const int t = q & (SEQ - 1), b = q >> 11;
    const int nsel = p.NSEL[q];
    __syncthreads();
    for (int i = tid; i < 1024; i += NTHR) qs[i] = p.QABS[(size_t)q * 1024 + i];
    sl[tid] = (tid < nsel) ? p.SEL[(size_t)q * 256 + tid] : 0;
    __syncthreads();
    {
      float acc[8];
#pragma unroll
      for (int h = 0; h < 8; ++h) acc[h] = 0.f;
      if (tid < nsel) {
        const int sj = sl[tid];
        const float* cr = p.CLAT + (size_t)(b * SEQ + sj) * 128;
        for (int c = 0; c < 128; c += 4) {
          const float4 cv = *(const float4*)&cr[c];
#pragma unroll
          for (int h = 0; h < 8; ++h) {
            const float4 qv = *(const float4*)&qs[h * 128 + c];
            acc[h] += cv.x * qv.x + cv.y * qv.y + cv.z * qv.z + cv.w * qv.w;
          }
        }
        const float dist = (float)(t - sj);
#pragma unroll
        for (int h = 0; h < 8; ++h) {
          const float slope = exp2f(-(float)(h + 1));
          pl[h * 256 + tid] = acc[h] * 0.125f - slope * dist;
        }
      } else {
#pragma unroll
        for (int h = 0; h < 8; ++h) pl[h * 256 + tid] = -1e30f;
      }
    }
    __syncthreads();
    for (int hh = 0; hh < 2; ++hh) {
      const int h = wv * 2 + hh;
      float v0 = pl[h * 256 + lane], v1 = pl[h * 256 + 64 + lane], v2 = pl[h * 256 + 128 + lane], v3 = pl[h * 256 + 192 + lane];
      const float m = wave_max(fmaxf(fmaxf(v0, v1), fmaxf(v2, v3)));
      v0 = expf(v0 - m); v1 = expf(v1 - m); v2 = expf(v2 - m); v3 = expf(v3 - m);
      const float s = wave_sum(v0 + v1 + v2 + v3);
      const float inv = 1.f / s;
      pl[h * 256 + lane] = v0 * inv; pl[h * 256 + 64 + lane] = v1 * inv;
      pl[h * 256 + 128 + lane] = v2 * inv; pl[h * 256 + 192 + lane] = v3 * inv;
    }
    __syncthreads();
    {
      const int c = tid & 127, hg = tid >> 7;
      float a0 = 0.f, a1 = 0.f, a2 = 0.f, a3 = 0.f;
      for (int j = 0; j < nsel; ++j) {
        const float cv = p.CLAT[(size_t)(b * SEQ + sl[j]) * 128 + c];
        a0 += pl[(hg * 4 + 0) * 256 + j] * cv;
        a1 += pl[(hg * 4 + 1) * 256 + j] * cv;
        a2 += pl[(hg * 4 + 2) * 256 + j] * cv;
        a3 += pl[(hg * 4 + 3) * 256 + j] * cv;
      }
      float* o = p.OLAT + (size_t)q * 1024;
      o[(hg * 4 + 0) * 128 + c] = a0;
      o[(hg * 4 + 1) * 128 + c] = a1;
      o[(hg * 4 + 2) * 128 + c] = a2;
      o[(hg * 4 + 3) * 128 + c] = a3;
    }
  }
}

__device__ void phase_uv(const Params& p, int bid, int nb, float* sm) {
  const int tid = threadIdx.x, ty = tid >> 4, tx = tid & 15;
  for (int item = bid; item < 256 * 8; item += nb) {
    const int h = item & 7, mt = item >> 3;
    auto aload = [&](int r, int k) -> float4 { return *(const float4*)&p.OLAT[(size_t)(mt * 64 + r) * 1024 + h * 128 + k]; };
    auto bload = [&](int k, int n) -> float4 { return *(const float4*)&p.w_uv[((size_t)h * 128 + k) * 64 + n]; };
    float acc[4][4];
    gemm_core<false>(128, aload, bload, acc, sm);
#pragma unroll
    for (int i = 0; i < 4; ++i)
      *(float4*)&p.OCAT[(size_t)(mt * 64 + ty * 4 + i) * 1024 + 512 + h * 64 + tx * 4] =
          make_float4(acc[i][0], acc[i][1], acc[i][2], acc[i][3]);
  }
}

#define ALPHA_RES 1.189207115002721f
__device__ void phase_outproj(const Params& p, int bid, int nb, float* sm) {
  const int tid = threadIdx.x, ty = tid >> 4, tx = tid & 15;
  for (int item = bid; item < 256 * 16; item += nb) {
    const int nt = item & 15, mt = item >> 4;
    const int bb = (mt * 64) >> 11;
    auto aload = [&](int r, int k) -> float4 { return *(const float4*)&p.OCAT[(size_t)(mt * 64 + r) * 1024 + k]; };
    auto bload = [&](int k, int n) -> float4 { return *(const float4*)&p.w_out[(size_t)k * 1024 + nt * 64 + n]; };
    float acc[4][4];
    gemm_core<false>(1024, aload, bload, acc, sm);
    const float4 gt = *(const float4*)&p.mod[bb * 6144 + 2048 + nt * 64 + tx * 4];
#pragma unroll
    for (int i = 0; i < 4; ++i) {
      const size_t off = (size_t)(mt * 64 + ty * 4 + i) * 1024 + nt * 64 + tx * 4;
      const float4 xv = *(const float4*)&p.x[off];
      *(float4*)&p.Y1[off] = make_float4(ALPHA_RES * xv.x + (1.f + gt.x) * acc[i][0], ALPHA_RES * xv.y + (1.f + gt.y) * acc[i][1],
                                         ALPHA_RES * xv.z + (1.f + gt.z) * acc[i][2], ALPHA_RES * xv.w + (1.f + gt.w) * acc[i][3]);
    }
  }
}

__device__ __forceinline__ float block_sum(float v, float* red) {
  v = wave_sum(v);
  __syncthreads();
  if ((threadIdx.x & 63) == 0) red[threadIdx.x >> 6] = v;
  __syncthreads();
  return red[0] + red[1] + red[2] + red[3];
}

__device__ void phase_ln1_router(const Params& p, int bid, int nb, float* sm) {
  const int tid = threadIdx.x;
  float* us = sm;
  float* red = sm + 1024;
  float* part = sm + 1040;
  float* lg = sm + 1040 + 256;
  for (int t = bid; t < T_TOK; t += nb) {
    const int b = t >> 11;
    const float4 y = *(const float4*)&p.Y1[(size_t)t * 1024 + tid * 4];
    const float mu = block_sum(y.x + y.y + y.z + y.w, red) * (1.f / 1024.f);
    const float d0 = y.x - mu, d1 = y.y - mu, d2 = y.z - mu, d3 = y.w - mu;
    const float var = block_sum(d0 * d0 + d1 * d1 + d2 * d2 + d3 * d3, red) * (1.f / 1024.f);
    const float rs = rsqrtf(var + 1e-5f);
    const float4 g = *(const float4*)&p.ln1_g[tid * 4];
    const float4 be = *(const float4*)&p.ln1_b[tid * 4];
    const float4 x1 = make_float4(d0 * rs * g.x + be.x, d1 * rs * g.y + be.y, d2 * rs * g.z + be.z, d3 * rs * g.w + be.w);
    *(float4*)&p.X1[(size_t)t * 1024 + tid * 4] = x1;
    const float4 sh = *(const float4*)&p.mod[b * 6144 + 3072 + tid * 4];
    const float4 sc = *(const float4*)&p.mod[b * 6144 + 4096 + tid * 4];
    *(float4*)&us[tid * 4] = make_float4(x1.x * (1.f + sc.x) + sh.x, x1.y * (1.f + sc.y) + sh.y, x1.z * (1.f + sc.z) + sh.z,
                                         x1.w * (1.f + sc.w) + sh.w);
    __syncthreads();
    {
      const int e = tid & 31, pt = tid >> 5;
      float a = 0.f;
      for (int k = pt * 128; k < pt * 128 + 128; ++k) a += us[k] * p.w_router[k * 32 + e];
      part[pt * 32 + e] = a;
    }
    __syncthreads();
    if (tid < 32) {
      float a = p.b_router[tid];
#pragma unroll
      for (int i = 0; i < 8; ++i) a += part[i * 32 + tid];
      lg[tid] = a;
    }
    __syncthreads();
    if (tid == 0) {
      int idx[4];
      float val[4];
      unsigned used = 0;
#pragma unroll
      for (int k = 0; k < 4; ++k) {
        float best = -3.4e38f;
        int bi = 0;
        for (int e = 0; e < 32; ++e) {
          const float v = lg[e];
          if (!((used >> e) & 1u) && v > best) { best = v; bi = e; }
        }
        used |= 1u << bi;
        idx[k] = bi;
        val[k] = best;
      }
      const float m = val[0];
      float ex[4], s = 0.f;
#pragma unroll
      for (int k = 0; k < 4; ++k) { ex[k] = expf(val[k] - m); s += ex[k]; }
#pragma unroll
      for (int k = 0; k < 4; ++k) {
        p.pgate[t * 4 + k] = ex[k] / s;
        const int pos = atomicAdd(&p.cnt[idx[k]], 1);
        p.lists[idx[k] * T_TOK + pos] = t * 4 + k;
      }
    }
    __syncthreads();
  }
}

__device__ __forceinline__ bool moe_item(const Params& p, int item, int ntn, int& e, int& mt, int& nt) {
  int base = 0;
  for (int ee = 0; ee < 32; ++ee) {
    const int tiles = (p.cnt[ee] + 63) >> 6;
    const int n = tiles * ntn;
    if (item < base + n) {
      const int loc = item - base;
      e = ee;
      nt = loc / tiles;
      mt = loc % tiles;
      return true;
    }
    base += n;
  }
  return false;
}

__device__ void phase_moe1(const Params& p, int bid, int nb, float* sm) {
  const int tid = threadIdx.x, ty = tid >> 4, tx = tid & 15;
  for (int item = bid;; item += nb) {
    int e, mt, nt;
    if (!moe_item(p, item, 32, e, mt, nt)) break;
    const int cnt = p.cnt[e];
    const int ar = tid >> 2;
    const int arow = mt * 64 + ar;
    const int apair = (arow < cnt) ? p.lists[e * T_TOK + arow] : -1;
    const int atok = apair >> 2;
    const float* xrow = p.X1 + (size_t)(apair < 0 ? 0 : atok) * 1024;
    const float* modb = p.mod + ((apair < 0 ? 0 : atok) >> 11) * 6144;
    auto aload = [&](int r, int k) -> float4 {
      if (apair < 0) return make_float4(0.f, 0.f, 0.f, 0.f);
      const float4 xv = *(const float4*)&xrow[k];
      const float4 sh = *(const float4*)&modb[3072 + k];
      const float4 sc = *(const float4*)&modb[4096 + k];
      return make_float4(xv.x * (1.f + sc.x) + sh.x, xv.y * (1.f + sc.y) + sh.y, xv.z * (1.f + sc.z) + sh.z,
                         xv.w * (1.f + sc.w) + sh.w);
    };
    auto bload = [&](int k, int n) -> float4 { return *(const float4*)&p.w_gu[((size_t)e * 1024 + k) * 2048 + nt * 64 + n]; };
    float acc[4][4];
    gemm_core<false>(1024, aload, bload, acc, sm);
    const float4 bg = *(const float4*)&p.b_gu[e * 2048 + nt * 64 + tx * 4];
#pragma unroll
    for (int i = 0; i < 4; ++i) {
      const int row = mt * 64 + ty * 4 + i;
      if (row < cnt) {
        const int pair = p.lists[e * T_TOK + row];
        float g0 = fminf(acc[i][0] + bg.x, 7.f), u0 = fminf(fmaxf(acc[i][1] + bg.y, -7.f), 7.f);
        float g1 = fminf(acc[i][2] + bg.z, 7.f), u1 = fminf(fmaxf(acc[i][3] + bg.w, -7.f), 7.f);
        const float h0 = (u0 + 1.f) * (g0 * sigmoidf_(g0 * 1.702f));
        const float h1 = (u1 + 1.f) * (g1 * sigmoidf_(g1 * 1.702f));
        *(float2*)&p.H[(size_t)pair * 1024 + nt * 32 + tx * 2] = make_float2(h0, h1);
      }
    }
  }
}

__device__ void phase_moe2(const Params& p, int bid, int nb, float* sm) {
  const int tid = threadIdx.x, ty = tid >> 4, tx = tid & 15;
  for (int item = bid;; item += nb) {
    int e, mt, nt;
    if (!moe_item(p, item, 16, e, mt, nt)) break;
    const int cnt = p.cnt[e];
    const int ar = tid >> 2;
    const int arow = mt * 64 + ar;
    const int apair = (arow < cnt) ? p.lists[e * T_TOK + arow] : -1;
    const float* hrow = p.H + (size_t)(apair < 0 ? 0 : apair) * 1024;
    auto aload = [&](int r, int k) -> float4 {
      if (apair < 0) return make_float4(0.f, 0.f, 0.f, 0.f);
      return *(const float4*)&hrow[k];
    };
    auto bload = [&](int k, int n) -> float4 { return *(const float4*)&p.w_dn[((size_t)e * 1024 + k) * 1024 + nt * 64 + n]; };
    float acc[4][4];
    gemm_core<false>(1024, aload, bload, acc, sm);
    const float4 bd = *(const float4*)&p.b_dn[e * 1024 + nt * 64 + tx * 4];
#pragma unroll
    for (int i = 0; i < 4; ++i) {
      const int row = mt * 64 + ty * 4 + i;
      if (row < cnt) {
        const int pair = p.lists[e * T_TOK + row];
        const float gt = p.pgate[pair];
        *(float4*)&p.PO[(size_t)pair * 1024 + nt * 64 + tx * 4] =
            make_float4((acc[i][0] + bd.x) * gt, (acc[i][1] + bd.y) * gt, (acc[i][2] + bd.z) * gt, (acc[i][3] + bd.w) * gt);
      }
    }
  }
}

__device__ void phase_final(const Params& p, int bid, int nb, float* sm) {
  const int tid = threadIdx.x;
  float* red = sm;
  for (int t = bid; t < T_TOK; t += nb) {
    const int b = t >> 11;
    float4 f = *(const float4*)&p.PO[((size_t)t * 4 + 0) * 1024 + tid * 4];
#pragma unroll
    for (int k = 1; k < 4; ++k) {
      const float4 v = *(const float4*)&p.PO[((size_t)t * 4 + k) * 1024 + tid * 4];
      f.x += v.x; f.y += v.y; f.z += v.z; f.w += v.w;
    }
    const float4 x1 = *(const float4*)&p.X1[(size_t)t * 1024 + tid * 4];
    const float4 gt = *(const float4*)&p.mod[b * 6144 + 5120 + tid * 4];
    const float y0 = ALPHA_RES * x1.x + (1.f + gt.x) * f.x, y1 = ALPHA_RES * x1.y + (1.f + gt.y) * f.y;
    const float y2 = ALPHA_RES * x1.z + (1.f + gt.z) * f.z, y3 = ALPHA_RES * x1.w + (1.f + gt.w) * f.w;
    const float mu = block_sum(y0 + y1 + y2 + y3, red) * (1.f / 1024.f);
    const float d0 = y0 - mu, d1 = y1 - mu, d2 = y2 - mu, d3 = y3 - mu;
    const float var = block_sum(d0 * d0 + d1 * d1 + d2 * d2 + d3 * d3, red) * (1.f / 1024.f);
    const float rs = rsqrtf(var + 1e-5f);
    const float4 g = *(const float4*)&p.ln2_g[tid * 4];
    const float4 be = *(const float4*)&p.ln2_b[tid * 4];
    *(float4*)&p.out[(size_t)t * 1024 + tid * 4] =
        make_float4(d0 * rs * g.x + be.x, d1 * rs * g.y + be.y, d2 * rs * g.z + be.z, d3 * rs * g.w + be.w);
  }
}

#define SMEM_FLOATS 10240
template <int PH>
__global__ void __launch_bounds__(NTHR) k_phase(Params p) {
  __shared__ __attribute__((aligned(16))) float sm[SMEM_FLOATS];
  const int bid = blockIdx.x, nb = gridDim.x;
  if (PH == 0) phase_ada(p, bid, nb, sm);
  if (PH == 1) phase_win(p, bid, nb, sm);
  if (PH == 2) { phase_prep_rwkv(p, bid, nb, sm); phase_prep_dsa(p, bid, nb, sm); }
  if (PH == 3) phase_qproj(p, bid, nb, sm);
  if (PH == 4) phase_qabs(p, bid, nb, sm);
  if (PH == 5) phase_scan(p, bid, nb, sm);
  if (PH == 6) phase_rwkv_fin(p, bid, nb, sm);
  if (PH == 7) phase_scores(p, bid, nb, sm);
  if (PH == 8) phase_topk(p, bid, nb, sm);
  if (PH == 9) phase_attn(p, bid, nb, sm);
  if (PH == 10) phase_uv(p, bid, nb, sm);
  if (PH == 11) phase_outproj(p, bid, nb, sm);
  if (PH == 12) phase_ln1_router(p, bid, nb, sm);
  if (PH == 13) phase_moe1(p, bid, nb, sm);
  if (PH == 14) phase_moe2(p, bid, nb, sm);
  if (PH == 15) phase_final(p, bid, nb, sm);
}

extern "C" void kernel_launch(void* const* d_in, const int* in_sizes, int n_in, void* d_out, int out_size, void* d_ws,
                              size_t ws_size, hipStream_t stream) {
  Params p{};
  const float** fp = (const float**)&p;
  for (int i = 0; i < 35; ++i) fp[i] = (const float*)d_in[i];
  p.out = (float*)d_out;
  float* w = (float*)d_ws;
  size_t off = 0;
  auto take = [&](size_t n) { float* r = w + off; off += (n + 63) & ~(size_t)63; return r; };
  p.mod = take(8 * 6144);
  p.X1 = take((size_t)T_TOK * 1024);
  p.pgate = take(T_TOK * 4);
  p.lists = (int*)take(32 * T_TOK);
  p.cnt = (int*)take(64);
  const size_t early = off;
  p.P = take((size_t)T_TOK * N_IN);
  p.SC = take((size_t)T_TOK * 8 * 384);
  p.G = take((size_t)T_TOK * 512);
  p.BV = take((size_t)T_TOK * 512);
  p.QLAT = take((size_t)T_TOK * 256);
  p.CLAT = take((size_t)T_TOK * 128);
  p.IK = take((size_t)T_TOK * 64);
  p.IW = take((size_t)T_TOK * 8);
  p.Q = take((size_t)T_TOK * 512);
  p.IQ = take((size_t)T_TOK * 512);
  p.QABS = take((size_t)T_TOK * 1024);
  p.SCORES = take((size_t)T_TOK * SEQ);
  p.SEL = (int*)take((size_t)T_TOK * 256);
  p.NSEL = (int*)take(T_TOK);
  p.ORAW = take((size_t)T_TOK * 512);
  p.OCAT = take((size_t)T_TOK * 1024);
  p.OLAT = take((size_t)T_TOK * 1024);
  p.Y1 = p.QABS;
  p.H = w + early;
  p.PO = p.H + (size_t)T_TOK * 4 * 1024;
  const int grid = 2048;
  k_phase<0><<<96, NTHR, 0, stream>>>(p);
  k_phase<1><<<grid, NTHR, 0, stream>>>(p);
  k_phase<2><<<grid, NTHR, 0, stream>>>(p);
  k_phase<3><<<grid, NTHR, 0, stream>>>(p);
  k_phase<4><<<grid, NTHR, 0, stream>>>(p);
  k_phase<5><<<256, NTHR, 0, stream>>>(p);
  k_phase<6><<<grid, NTHR, 0, stream>>>(p);
  k_phase<7><<<grid, NTHR, 0, stream>>>(p);
  k_phase<8><<<grid, NTHR, 0, stream>>>(p);
  k_phase<9><<<grid, NTHR, 0, stream>>>(p);
  k_phase<10><<<grid, NTHR, 0, stream>>>(p);
  k_phase<11><<<grid, NTHR, 0, stream>>>(p);
  k_phase<12><<<grid, NTHR, 0, stream>>>(p);
  k_phase<13><<<grid, NTHR, 0, stream>>>(p);
  k_phase<14><<<grid, NTHR, 0, stream>>>(p);
  k_phase<15><<<grid, NTHR, 0, stream>>>(p);
}
```

```cpp
#include <hip/hip_runtime.h>
#include <hip/hip_cooperative_groups.h>
#include <stdint.h>

#define T_TOK 16384
#define SEQ 2048
#define NBATCH 8
#define DM 1024
#define N_IN 2248
#define N_SHIFT 1792
#define NTHR 256
__device__ __forceinline__ int fresh_tid() { int t = threadIdx.x & 255; asm volatile("" : "+v"(t)); return t; }
__device__ __forceinline__ int fresh_tid512() { int t = threadIdx.x; asm volatile("" : "+v"(t)); return t; }
__device__ __forceinline__ int half_id() { return __builtin_amdgcn_readfirstlane((int)(threadIdx.x >> 8)); }
#define CNT_STRIDE 32

struct Params {
  const float *x, *c, *w_ada, *b_ada, *w_in, *shift_mu, *w0, *w2, *a0, *a2, *g2, *k_k, *k_a, *r_k, *ln_w, *ln_b,
      *q_norm, *w_q_up, *kv_norm, *w_uk, *w_uv, *idx_w_q, *idx_ln_g, *idx_ln_b, *w_out, *ln1_g, *ln1_b, *w_router,
      *b_router, *w_gu, *b_gu, *w_dn, *b_dn, *ln2_g, *ln2_b;
  float* out;
  float *mod, *P, *SC, *G, *BV, *IW, *QABS, *SCORES, *ORAW, *Y1, *X1, *pgate;
  int *SEL, *NSEL, *lists, *cnt;
  unsigned* bar;
  int* moe_done;
  unsigned short *WinT, *WoutT, *WguT, *WdnT;
  float* lgate;
  unsigned short *U2, *Hb, *POb, *U1, *QLATb, *Qb, *IQb, *IKb, *OCATb, *OLATb, *QABSb, *CLATb;
};

__device__ __forceinline__ float fexp(float v) { return __builtin_amdgcn_exp2f(v * 1.4426950408889634f); }
__device__ __forceinline__ float frcp(float v) { return __builtin_amdgcn_rcpf(v); }
__device__ __forceinline__ float sigmoidf_(float v) { return frcp(1.0f + fexp(-v)); }
__device__ __forceinline__ float ftanh(float v) { return 1.0f - 2.0f * frcp(fexp(2.0f * v) + 1.0f); }
__device__ __forceinline__ float fsoftplus(float z) {
  return fmaxf(z, 0.f) + __builtin_amdgcn_logf(1.0f + fexp(-fabsf(z))) * 0.6931471805599453f;
}

template <int CTRL, int ROWMASK>
__device__ __forceinline__ float dpp_addf(float v) {
  return v + __builtin_bit_cast(float, __builtin_amdgcn_update_dpp(0, __builtin_bit_cast(int, v), CTRL, ROWMASK, 0xF, false));
}
__device__ __forceinline__ float wave_sum(float v) {
  v = dpp_addf<0x111, 0xF>(v);
  v = dpp_addf<0x112, 0xF>(v);
  v = dpp_addf<0x114, 0xF>(v);
  v = dpp_addf<0x118, 0xF>(v);
  v = dpp_addf<0x142, 0xA>(v);
  v = dpp_addf<0x143, 0xC>(v);
  return __builtin_bit_cast(float, __builtin_amdgcn_readlane(__builtin_bit_cast(int, v), 63));
}


#define XB_TMO      128
#define XB_XCNT(j)  (256  + 64 * (j))
#define XB_XSUB(j)  (1280 + 64 * (j))
#define XB_XGEN(j)  (2304 + 64 * (j))
#define XB_TOP      3328
#define XB_TOPGEN   3392
#define XCD_BAR_WORDS 3456
#define XB_SPIN_CAP (1u << 22)
#define LAS __attribute__((address_space(3)))
__device__ __forceinline__ unsigned xb_ld(unsigned* p) { return __hip_atomic_load(p, __ATOMIC_RELAXED, __HIP_MEMORY_SCOPE_AGENT); }
__device__ __forceinline__ unsigned xb_add(unsigned* p, unsigned v) { return __hip_atomic_fetch_add(p, v, __ATOMIC_RELAXED, __HIP_MEMORY_SCOPE_AGENT); }
__device__ __forceinline__ unsigned xb_xcc_id() { return (unsigned)__builtin_amdgcn_s_getreg((3 << 11) | 20) & 0xFu; }
#define XB_SPIN(cond, bar) do { unsigned _sp = 0; while (cond) { __builtin_amdgcn_s_sleep(1); \
    if ((++_sp & 255u) == 0u) { if (xb_ld(&(bar)[XB_TMO])) break; if (_sp > XB_SPIN_CAP) { atomicAdd(&(bar)[XB_TMO], 1u); break; } } } } while (0)
struct XcdBarrier { unsigned* bar; unsigned x; volatile LAS unsigned* st; };
__device__ __forceinline__ XcdBarrier xcd_barrier_post(unsigned* bar, volatile LAS unsigned* st) {
  XcdBarrier b; b.bar = bar; b.x = xb_xcc_id(); b.st = st;
  if (threadIdx.x == 0) st[2] = xb_add(&bar[XB_XCNT(b.x)], 1u);
  return b;
}
__device__ __forceinline__ void xcd_barrier_complete(unsigned* bar, unsigned x, unsigned& nloc, unsigned& nx) {
  const unsigned G = gridDim.x * gridDim.y * gridDim.z;
  unsigned sum, cnt, mine, sp = 0u;
  for (;;) {
    sum = 0u; cnt = 0u; mine = 0u;
#pragma unroll
    for (unsigned j = 0; j < 16; ++j) { const unsigned c = xb_ld(&bar[XB_XCNT(j)]); sum += c; cnt += (c > 0u) ? 1u : 0u; mine = (j == x) ? c : mine; }
    if (sum == G) break;
    __builtin_amdgcn_s_sleep(1);
    if ((++sp & 255u) == 0u) { if (xb_ld(&bar[XB_TMO])) break; if (sp > XB_SPIN_CAP) { atomicAdd(&bar[XB_TMO], 1u); break; } }
  }
  nloc = mine > 0u ? mine : 1u; nx = cnt > 0u ? cnt : 1u;
}
__device__ __forceinline__ void xcd_barrier(const XcdBarrier& b) {
  asm volatile("s_waitcnt vmcnt(0)" ::: "memory");
  __syncthreads();
  if (threadIdx.x == 0) {
    unsigned* bar = b.bar;
    __builtin_amdgcn_s_waitcnt(0);
    unsigned nloc = b.st[0], nx = b.st[1];
    if (nloc == 0u) { xcd_barrier_complete(bar, b.x, nloc, nx); b.st[0] = nloc; b.st[1] = nx; }
    const unsigned old = xb_add(&bar[XB_XSUB(b.x)], 1u);
    const unsigned gen = old / nloc;
    if (old + 1u == (gen + 1u) * nloc) {
      __builtin_amdgcn_fence(__ATOMIC_RELEASE, "agent");
      asm volatile("s_waitcnt vmcnt(0)" ::: "memory");
      const unsigned og = xb_add(&bar[XB_TOP], 1u);
      const unsigned tg = og / nx;
      if (og + 1u == (tg + 1u) * nx) xb_add(&bar[XB_TOPGEN], 1u);
      else XB_SPIN(xb_ld(&bar[XB_TOPGEN]) == tg, bar);
      __builtin_amdgcn_fence(__ATOMIC_ACQUIRE, "agent");
      xb_add(&bar[XB_XGEN(b.x)], 1u);
      asm volatile("s_waitcnt vmcnt(0)" ::: "memory");
    } else {
      XB_SPIN(xb_ld(&bar[XB_XGEN(b.x)]) == gen, bar);
      __builtin_amdgcn_fence(__ATOMIC_ACQUIRE, "agent");
      asm volatile("s_waitcnt vmcnt(0)" ::: "memory");
    }
  }
  __syncthreads();
}


__device__ __forceinline__ int xcd_virtual_bid(const XcdBarrier& b) {
  if (threadIdx.x == 0) {
    unsigned base = 0;
    for (unsigned j = 0; j < b.x; ++j) base += xb_ld(&b.bar[XB_XCNT(j)]);
    b.st[3] = base + b.st[2];
  }
  __syncthreads();
  return __builtin_amdgcn_readfirstlane((int)b.st[3]);
}


typedef __attribute__((ext_vector_type(8))) short bf16x8_t;
typedef __attribute__((ext_vector_type(16))) float f32x16;
typedef unsigned short bf16_t;
#define LSTR 40
#define STG_ELEMS (128 * LSTR)

__device__ __forceinline__ unsigned pack_bf16(float a, float b) {
  __bf16 x = (__bf16)a, y = (__bf16)b;
  return (unsigned)__builtin_bit_cast(unsigned short, x) | ((unsigned)__builtin_bit_cast(unsigned short, y) << 16);
}
__device__ __forceinline__ bf16_t to_bf16(float a) {
  __bf16 x = (__bf16)a;
  return __builtin_bit_cast(unsigned short, x);
}
typedef __attribute__((ext_vector_type(4))) unsigned u32x4_t;
__device__ __forceinline__ unsigned cvt_pk(float a, float b) {
  unsigned r;
  asm("v_cvt_pk_bf16_f32 %0, %1, %2" : "=v"(r) : "v"(a), "v"(b));
  return r;
}
__device__ __forceinline__ __amdgpu_buffer_rsrc_t make_rsrc(const void* p) {
  return __builtin_amdgcn_make_buffer_rsrc((void*)p, 0, 0x7fffffff, 0x00020000);
}
__device__ __forceinline__ float bf16_lo(unsigned u) { return __uint_as_float(u << 16); }
__device__ __forceinline__ float bf16_hi(unsigned u) { return __uint_as_float(u & 0xFFFF0000u); }

struct LoadRowsBF16 {
  __amdgpu_buffer_rsrc_t rs;
  int v0off, v1off;
  int o0, o1;
  struct Regs { u32x4_t v0, v1; };
  __device__ __forceinline__ Regs fetch(int k0) const {
    Regs r;
    r.v0 = __builtin_amdgcn_raw_buffer_load_b128(rs, v0off, k0 * 2, 0);
    r.v1 = __builtin_amdgcn_raw_buffer_load_b128(rs, v1off, k0 * 2, 0);
    return r;
  }
  __device__ __forceinline__ void commit(bf16_t* S, const Regs r) const {
    *(u32x4_t*)(S + o0) = r.v0;
    *(u32x4_t*)(S + o1) = r.v1;
  }
};
struct LoadWeightKN {
  __amdgpu_buffer_rsrc_t rs;
  int soff;
  int ldb4;
  int voff;
  int o;
  struct Regs { float v0, v1, v2, v3, v4, v5, v6, v7, v8, v9, v10, v11, v12, v13, v14, v15; };
#define LW_LD(J) __builtin_bit_cast(float, __builtin_amdgcn_raw_buffer_load_b32(rs, voff, so + (J) * ldb4, 0))
  __device__ __forceinline__ Regs fetch(int k0) const {
    Regs r;
    const int so = soff + k0 * ldb4;
    r.v0 = LW_LD(0); r.v1 = LW_LD(1); r.v2 = LW_LD(2); r.v3 = LW_LD(3); r.v4 = LW_LD(4); r.v5 = LW_LD(5); r.v6 = LW_LD(6); r.v7 = LW_LD(7);
    r.v8 = LW_LD(8); r.v9 = LW_LD(9); r.v10 = LW_LD(10); r.v11 = LW_LD(11); r.v12 = LW_LD(12); r.v13 = LW_LD(13); r.v14 = LW_LD(14); r.v15 = LW_LD(15);
    return r;
  }
#undef LW_LD
  __device__ __forceinline__ void commit(bf16_t* S, const Regs r) const {
    u32x4_t w0, w1;
    w0[0] = cvt_pk(r.v0, r.v1); w0[1] = cvt_pk(r.v2, r.v3); w0[2] = cvt_pk(r.v4, r.v5); w0[3] = cvt_pk(r.v6, r.v7);
    w1[0] = cvt_pk(r.v8, r.v9); w1[1] = cvt_pk(r.v10, r.v11); w1[2] = cvt_pk(r.v12, r.v13); w1[3] = cvt_pk(r.v14, r.v15);
    *(u32x4_t*)(S + o) = w0;
    *(u32x4_t*)(S + o + 8) = w1;
  }
};

struct NoStepFn { __device__ __forceinline__ void operator()(int, f32x16 (&)[2][2]) const {} };
template <class AL, class BL, class SF = NoStepFn>
__device__ __forceinline__ void mfma_gemm128(int K, const AL& A, const BL& B, f32x16 (&acc)[2][2], bf16_t* sm, int kstart = 0,
                                             int kmaskB = -1, const SF& step = SF()) {
  const int tid = fresh_tid(), lane = tid & 63, wv = tid >> 6;
  const int wr = wv >> 1, wc = wv & 1, r = lane & 31, hh = lane >> 5;
#pragma unroll
  for (int i = 0; i < 2; ++i)
#pragma unroll
    for (int j = 0; j < 2; ++j)
#pragma unroll
      for (int q = 0; q < 16; ++q) acc[i][j][q] = 0.f;
  __syncthreads();
  typename AL::Regs ra = A.fetch(kstart);
  typename BL::Regs rb = B.fetch(kstart & kmaskB);
  A.commit(sm, ra);
  B.commit(sm + STG_ELEMS, rb);
  __syncthreads();
  const int aoff = (wr * 64 + r) * LSTR + hh * 8;
  const int boff = (wc * 64 + r) * LSTR + hh * 8;
  const int nk = K >> 5;
  for (int it = 0; it < nk; ++it) {
    const bf16_t* As = sm + (it & 1) * 2 * STG_ELEMS;
    const bf16_t* Bs = As + STG_ELEMS;
    bf16_t* An = sm + ((it & 1) ^ 1) * 2 * STG_ELEMS;
    int kn = kstart + ((it + 1 < nk) ? (it + 1) * 32 : it * 32);
    kn = (kn >= K) ? kn - K : kn;
    ra = A.fetch(kn);
    rb = B.fetch(kn & kmaskB);
#pragma unroll
    for (int ks = 0; ks < 2; ++ks) {
      const bf16x8_t a0 = *(const bf16x8_t*)(As + aoff + ks * 16);
      const bf16x8_t a1 = *(const bf16x8_t*)(As + aoff + 32 * LSTR + ks * 16);
      const bf16x8_t b0 = *(const bf16x8_t*)(Bs + boff + ks * 16);
      const bf16x8_t b1 = *(const bf16x8_t*)(Bs + boff + 32 * LSTR + ks * 16);
      acc[0][0] = __builtin_amdgcn_mfma_f32_32x32x16_bf16(a0, b0, acc[0][0], 0, 0, 0);
      acc[0][1] = __builtin_amdgcn_mfma_f32_32x32x16_bf16(a0, b1, acc[0][1], 0, 0, 0);
      acc[1][0] = __builtin_amdgcn_mfma_f32_32x32x16_bf16(a1, b0, acc[1][0], 0, 0, 0);
      acc[1][1] = __builtin_amdgcn_mfma_f32_32x32x16_bf16(a1, b1, acc[1][1], 0, 0, 0);
    }
    step(it, acc);
    if (it + 1 < nk) {
      A.commit(An, ra);
      B.commit(An + STG_ELEMS, rb);
    }
    __syncthreads();
  }
}

#define STG2_ELEMS ((256 + 128) * LSTR)
struct LoadRows4 {
  __amdgpu_buffer_rsrc_t rs;
  int off0, off1, off2, off3;
  int o;
  struct Regs { u32x4_t v0, v1, v2, v3; };
  __device__ __forceinline__ Regs fetch(int k0) const {
    Regs r;
    r.v0 = __builtin_amdgcn_raw_buffer_load_b128(rs, off0, k0 * 2, 0);
    r.v1 = __builtin_amdgcn_raw_buffer_load_b128(rs, off1, k0 * 2, 0);
    r.v2 = __builtin_amdgcn_raw_buffer_load_b128(rs, off2, k0 * 2, 0);
    r.v3 = __builtin_amdgcn_raw_buffer_load_b128(rs, off3, k0 * 2, 0);
    return r;
  }
  __device__ __forceinline__ void commit(bf16_t* S, const Regs r) const {
    *(u32x4_t*)(S + o) = r.v0;
    *(u32x4_t*)(S + o + 64 * LSTR) = r.v1;
    *(u32x4_t*)(S + o + 128 * LSTR) = r.v2;
    *(u32x4_t*)(S + o + 192 * LSTR) = r.v3;
  }
};

template <class AL, class BL>
__device__ __forceinline__ void mfma_gemm256(int K, const AL& A, const BL& B, f32x16 (&acc)[4][2], bf16_t* sm, int kstart) {
  const int tid = fresh_tid(), lane = tid & 63, wv = tid >> 6;
  const int wr = wv >> 1, wc = wv & 1, r = lane & 31, hh = lane >> 5;
#pragma unroll
  for (int i = 0; i < 4; ++i)
#pragma unroll
    for (int j = 0; j < 2; ++j)
#pragma unroll
      for (int q = 0; q < 16; ++q) acc[i][j][q] = 0.f;
  __syncthreads();
  typename AL::Regs ra = A.fetch(kstart);
  typename BL::Regs rb = B.fetch(kstart);
  A.commit(sm, ra);
  B.commit(sm + 256 * LSTR, rb);
  __syncthreads();
  const int aoff = (wr * 128 + r) * LSTR + hh * 8;
  const int boff = (256 + wc * 64 + r) * LSTR + hh * 8;
  const int nk = K >> 5;
  for (int it = 0; it < nk; ++it) {
    const bf16_t* S = sm + (it & 1) * STG2_ELEMS;
    bf16_t* Sn = sm + ((it & 1) ^ 1) * STG2_ELEMS;
    int kn = kstart + ((it + 1 < nk) ? (it + 1) * 32 : it * 32);
    kn = (kn >= K) ? kn - K : kn;
    ra = A.fetch(kn);
    rb = B.fetch(kn);
#pragma unroll
    for (int ks = 0; ks < 2; ++ks) {
      const bf16x8_t b0 = *(const bf16x8_t*)(S + boff + ks * 16);
      const bf16x8_t b1 = *(const bf16x8_t*)(S + boff + 32 * LSTR + ks * 16);
#pragma unroll
      for (int mi = 0; mi < 4; ++mi) {
        const bf16x8_t a = *(const bf16x8_t*)(S + aoff + mi * 32 * LSTR + ks * 16);
        acc[mi][0] = __builtin_amdgcn_mfma_f32_32x32x16_bf16(a, b0, acc[mi][0], 0, 0, 0);
        acc[mi][1] = __builtin_amdgcn_mfma_f32_32x32x16_bf16(a, b1, acc[mi][1], 0, 0, 0);
      }
    }
    if (it + 1 < nk) {
      A.commit(Sn, ra);
      B.commit(Sn + 256 * LSTR, rb);
    }
    __syncthreads();
  }
}


__device__ __forceinline__ void phase_ada(const Params& p, int bid, int nb, float* sm) {
  const int tid = fresh_tid();
  float* cact = sm;
  float* red = sm + 8192;
  if (bid == 0 && tid < 32) p.cnt[tid * CNT_STRIDE] = 0;
  if (bid == 2) for (int i = tid; i < 32 * 64; i += NTHR) p.moe_done[i] = 0;
  for (int i = tid; i < 8192; i += NTHR) {
    const float v = p.c[i];
    cact[(i & 1023) * 8 + (i >> 10)] = v / (1.0f + expf(-v));
  }
  __syncthreads();
  for (int item = bid; item < 384; item += nb) {
    const int cl = tid & 15, kg = tid >> 4;
    const int col = item * 16 + cl;
    float a0 = 0.f, a1 = 0.f, a2 = 0.f, a3 = 0.f, a4 = 0.f, a5 = 0.f, a6 = 0.f, a7 = 0.f;
    const float* wp = p.w_ada + (size_t)(kg * 64) * 6144 + col;
    float wn0 = wp[0 * 6144], wn1 = wp[1 * 6144], wn2 = wp[2 * 6144], wn3 = wp[3 * 6144], wn4 = wp[4 * 6144], wn5 = wp[5 * 6144],
          wn6 = wp[6 * 6144], wn7 = wp[7 * 6144];
    for (int k0 = 0; k0 < 64; k0 += 8) {
      const float wc0 = wn0, wc1 = wn1, wc2 = wn2, wc3 = wn3, wc4 = wn4, wc5 = wn5, wc6 = wn6, wc7 = wn7;
      const float* wq = wp + (size_t)((k0 + 8 < 64) ? k0 + 8 : k0) * 6144;
      wn0 = wq[0 * 6144]; wn1 = wq[1 * 6144]; wn2 = wq[2 * 6144]; wn3 = wq[3 * 6144];
      wn4 = wq[4 * 6144]; wn5 = wq[5 * 6144]; wn6 = wq[6 * 6144]; wn7 = wq[7 * 6144];
      const float* cb = cact + (kg * 64 + k0) * 8;
#define ADA_STEP(KK, W)                                                                                 \
  {                                                                                                     \
    const float4 ca = *(const float4*)&cb[(KK) * 8], cc = *(const float4*)&cb[(KK) * 8 + 4];            \
    a0 = fmaf(ca.x, W, a0); a1 = fmaf(ca.y, W, a1); a2 = fmaf(ca.z, W, a2); a3 = fmaf(ca.w, W, a3);     \
    a4 = fmaf(cc.x, W, a4); a5 = fmaf(cc.y, W, a5); a6 = fmaf(cc.z, W, a6); a7 = fmaf(cc.w, W, a7);     \
  }
      ADA_STEP(0, wc0) ADA_STEP(1, wc1) ADA_STEP(2, wc2) ADA_STEP(3, wc3) ADA_STEP(4, wc4) ADA_STEP(5, wc5) ADA_STEP(6, wc6) ADA_STEP(7, wc7)
#undef ADA_STEP
    }
    float* rp = red + kg * 128 + cl;
    rp[0 * 16] = a0; rp[1 * 16] = a1; rp[2 * 16] = a2; rp[3 * 16] = a3; rp[4 * 16] = a4; rp[5 * 16] = a5; rp[6 * 16] = a6; rp[7 * 16] = a7;
    __syncthreads();
    if (tid < 128) {
      const int b = tid >> 4, cc = tid & 15;
      float sacc = p.b_ada[item * 16 + cc];
#pragma unroll
      for (int g = 0; g < 16; ++g) sacc += red[g * 128 + b * 16 + cc];
      p.mod[b * 6144 + item * 16 + cc] = sacc;
    }
    __syncthreads();
  }
}

__device__ __forceinline__ void setup_rows(LoadRowsBF16& A, const bf16_t* arr, size_t origin, unsigned stride) {
  const int tid = fresh_tid(), row0 = tid >> 2, kc = tid & 3;
  A.rs = make_rsrc(arr);
  A.v0off = (int)((origin + (size_t)row0 * stride) * 2) + kc * 16;
  A.v1off = (int)((origin + (size_t)(row0 + 64) * stride) * 2) + kc * 16;
  A.o0 = row0 * LSTR + kc * 8;
  A.o1 = (row0 + 64) * LSTR + kc * 8;
}
__device__ __forceinline__ void setup_weight(LoadWeightKN& B, const float* arr, size_t origin, int ldb, int cmax) {
  const int tid = fresh_tid(), cl = tid & 127;
  const int kh = __builtin_amdgcn_readfirstlane(tid >> 7);
  B.rs = make_rsrc(arr);
  B.ldb4 = ldb * 4;
  B.soff = (int)((origin + (size_t)(kh * 16) * ldb) * 4);
  B.voff = (cl < cmax ? cl : cmax) * 4;
  B.o = cl * LSTR + kh * 16;
}
#define ACC_ROW(mi, q) (wr * 64 + (mi) * 32 + ((q) & 3) + 8 * ((q) >> 2) + 4 * hh)
#define ACC_COL(ni) (wc * 64 + (ni) * 32 + r)
#define MFMA_IDS                                              \
  const int tid = fresh_tid(), lane = tid & 63, wv = tid >> 6; \
  const int wr = wv >> 1, wc = wv & 1, r = lane & 31, hh = lane >> 5; \
  (void)tid; (void)wr; (void)wc; (void)r; (void)hh;

__device__ __forceinline__ void phase_u1(const Params& p, int bid, int nb) {
  for (size_t i = (size_t)bid * NTHR + fresh_tid(); i < (size_t)T_TOK * 128; i += (size_t)nb * NTHR) {
    const int t = (int)(i >> 7), k = (int)(i & 127) * 8;
    const float* modb = p.mod + (t >> 11) * 6144;
    const float4 x0 = *(const float4*)&p.x[(size_t)t * 1024 + k], x1 = *(const float4*)&p.x[(size_t)t * 1024 + k + 4];
    const float4 c0 = *(const float4*)&modb[1024 + k], c1 = *(const float4*)&modb[1024 + k + 4];
    const float4 h0 = *(const float4*)&modb[k], h1 = *(const float4*)&modb[k + 4];
    uint4 o;
    o.x = pack_bf16(x0.x * (1.f + c0.x) + h0.x, x0.y * (1.f + c0.y) + h0.y);
    o.y = pack_bf16(x0.z * (1.f + c0.z) + h0.z, x0.w * (1.f + c0.w) + h0.w);
    o.z = pack_bf16(x1.x * (1.f + c1.x) + h1.x, x1.y * (1.f + c1.y) + h1.y);
    o.w = pack_bf16(x1.z * (1.f + c1.z) + h1.z, x1.w * (1.f + c1.w) + h1.w);
    *(uint4*)&p.U1[(size_t)t * 1024 + k] = o;
  }
}

__device__ __forceinline__ void setup_rows4(LoadRows4& A, const bf16_t* arr, size_t origin, unsigned stride) {
  const int tid = fresh_tid(), row0 = tid >> 2, kc = tid & 3;
  A.rs = make_rsrc(arr);
  A.off0 = (int)((origin + (size_t)row0 * stride) * 2) + kc * 16;
  A.off1 = (int)((origin + (size_t)(row0 + 64) * stride) * 2) + kc * 16;
  A.off2 = (int)((origin + (size_t)(row0 + 128) * stride) * 2) + kc * 16;
  A.off3 = (int)((origin + (size_t)(row0 + 192) * stride) * 2) + kc * 16;
  A.o = row0 * LSTR + kc * 8;
}
#define ACC_ROW4(mi, q) (wr * 128 + (mi) * 32 + ((q) & 3) + 8 * ((q) >> 2) + 4 * hh)

#define EP_STR 68
template <class FN>
__device__ __forceinline__ void epilogue256_staged(const f32x16 (&acc)[4][2], float* smf, const FN& fn) {
  const int tid = fresh_tid(), lane = tid & 63, wv = tid >> 6;
  const int r = lane & 31, hh = lane >> 5;
  for (int pass = 0; pass < 4; ++pass) {
    if (wv == pass) {
#pragma unroll
      for (int mi = 0; mi < 4; ++mi)
#pragma unroll
        for (int q = 0; q < 16; ++q) {
          const int row = mi * 32 + (q & 3) + 8 * (q >> 2) + 4 * hh;
          smf[row * EP_STR + r] = acc[mi][0][q];
          smf[row * EP_STR + 32 + r] = acc[mi][1][q];
        }
    }
    __syncthreads();
    const int rh = pass >> 1, chh = pass & 1;
#pragma unroll
    for (int i = 0; i < 8; ++i) {
      const int c = tid + i * NTHR, row = c >> 4, c4 = (c & 15) * 4;
      const float4 v = *(const float4*)&smf[row * EP_STR + c4];
      fn(rh * 128 + row, chh * 64 + c4, v);
    }
    __syncthreads();
  }
}
__device__ __forceinline__ void phase_win(const Params& p, int bid, int nb, float* smf) {
  bf16_t* sm = (bf16_t*)smf;
  MFMA_IDS
  for (int item = bid; item < 64 * 18; item += nb) {
    const int nt = item % 18, mt = item / 18;
    LoadRows4 A;
    setup_rows4(A, p.U1, (size_t)mt * 256 * 1024, 1024);
    LoadWeightKN B;
    setup_weight(B, p.w_in, (size_t)nt * 128, N_IN, N_IN - 1 - nt * 128);
    f32x16 acc[4][2];
    mfma_gemm256(1024, A, B, acc, sm, 0);
    epilogue256_staged(acc, smf, [&](int row, int col, const float4& v) {
      if (nt * 128 + col < N_IN) *(float4*)&p.P[(size_t)(mt * 256 + row) * N_IN + nt * 128 + col] = v;
    });
  }
}

__device__ __forceinline__ float psh(const Params& p, int t, int s, int j) {
  const float cur = p.P[(size_t)t * N_IN + j];
  const float mu = p.shift_mu[j];
  const float pl = p.P[(size_t)(s == 0 ? t : t - 1) * N_IN + j];
  const float prev = (s == 0) ? 0.f : pl;
  return cur + mu * (prev - cur);
}

#define PR_TOK 32
#define PR_FMA4(ACC, B, V4, W)                                                                         \
  ACC[(B) + 0] = fmaf(V4.x, W, ACC[(B) + 0]); ACC[(B) + 1] = fmaf(V4.y, W, ACC[(B) + 1]);              \
  ACC[(B) + 2] = fmaf(V4.z, W, ACC[(B) + 2]); ACC[(B) + 3] = fmaf(V4.w, W, ACC[(B) + 3]);
__device__ __forceinline__ void phase_prep_rwkv(const Params& p, int bid, int nb, float* sm) {
  const int tid = fresh_tid();
  float* actw = sm;
  float* acta = sm + 64 * PR_TOK;
  float* actg = sm + 128 * PR_TOK;
  for (int item = bid; item < T_TOK / PR_TOK; item += nb) {
    const int t0 = item * PR_TOK;
    __syncthreads();
    {
      const int jj = tid;
      const float mu = p.shift_mu[1536 + jj];
      const float* pc = p.P + (size_t)t0 * N_IN + 1536 + jj;
      float prevv = ((t0 & (SEQ - 1)) == 0) ? 0.f : pc[-(ptrdiff_t)N_IN];
      for (int g8 = 0; g8 < PR_TOK; g8 += 8) {
        float cv[8];
#pragma unroll
        for (int u = 0; u < 8; ++u) cv[u] = pc[(size_t)(g8 + u) * N_IN];
#pragma unroll
        for (int u = 0; u < 8; ++u) {
          const float v = cv[u] + mu * (prevv - cv[u]);
          prevv = cv[u];
          const int tk = g8 + u;
          if (jj < 64) actw[jj * PR_TOK + tk] = ftanh(v);
          else if (jj < 128) acta[(jj - 64) * PR_TOK + tk] = v;
          else actg[(jj - 128) * PR_TOK + tk] = sigmoidf_(v);
        }
      }
    }
    __syncthreads();
    const int c0 = tid, c1 = tid + 256;
    const unsigned nlo = (unsigned)(tid & 63), tidu = (unsigned)tid;
    const int hA = __builtin_amdgcn_readfirstlane(tid >> 6);
    float* scuA = p.SC + ((size_t)(((t0 >> 11) * 8 + hA) * SEQ + (t0 & (SEQ - 1)))) * 384;
    float* scuB = scuA + (size_t)4 * SEQ * 384;
#define PR_H 16
#define PR_STEP2(JJ, WA, WB, ACCA, ACCB)                                      \
  _Pragma("unroll") for (int tq = 0; tq < PR_H / 4; ++tq) {                   \
    const float4 v4 = *(const float4*)&ab[(JJ) * PR_TOK + tq * 4];            \
    PR_FMA4(ACCA, tq * 4, v4, WA)                                             \
    PR_FMA4(ACCB, tq * 4, v4, WB)                                             \
  }
#define PR_LW(JJ, VO) __builtin_bit_cast(float, __builtin_amdgcn_raw_buffer_load_b32(wrs_, (VO), (JJ) * 2048, 0))
#define PR_PASS2(J, WARR, ACT, ACCA, ACCB)                                                           \
  {                                                                                                  \
    const __amdgpu_buffer_rsrc_t wrs_ = make_rsrc(p.WARR);   \
    const int voa_ = c0 * 4, vob_ = c1 * 4;                                                          \
    float na0 = PR_LW(0, voa_), na1 = PR_LW(1, voa_), na2 = PR_LW(2, voa_), na3 = PR_LW(3, voa_),    \
          na4 = PR_LW(4, voa_), na5 = PR_LW(5, voa_), na6 = PR_LW(6, voa_), na7 = PR_LW(7, voa_);    \
    float nb0 = PR_LW(0, vob_), nb1 = PR_LW(1, vob_), nb2 = PR_LW(2, vob_), nb3 = PR_LW(3, vob_),    \
          nb4 = PR_LW(4, vob_), nb5 = PR_LW(5, vob_), nb6 = PR_LW(6, vob_), nb7 = PR_LW(7, vob_);    \
    for (int j0 = 0; j0 < (J); j0 += 8) {                                                            \
      const float ca0 = na0, ca1 = na1, ca2 = na2, ca3 = na3, ca4 = na4, ca5 = na5, ca6 = na6, ca7 = na7;       \
      const float cb0 = nb0, cb1 = nb1, cb2 = nb2, cb3 = nb3, cb4 = nb4, cb5 = nb5, cb6 = nb6, cb7 = nb7;       \
      const int jn_ = (j0 + 8 < (J)) ? j0 + 8 : j0;                 \
      na0 = PR_LW(jn_, voa_); na1 = PR_LW(jn_ + 1, voa_); na2 = PR_LW(jn_ + 2, voa_); na3 = PR_LW(jn_ + 3, voa_);   \
      na4 = PR_LW(jn_ + 4, voa_); na5 = PR_LW(jn_ + 5, voa_); na6 = PR_LW(jn_ + 6, voa_); na7 = PR_LW(jn_ + 7, voa_); \
      nb0 = PR_LW(jn_, vob_); nb1 = PR_LW(jn_ + 1, vob_); nb2 = PR_LW(jn_ + 2, vob_); nb3 = PR_LW(jn_ + 3, vob_);   \
      nb4 = PR_LW(jn_ + 4, vob_); nb5 = PR_LW(jn_ + 5, vob_); nb6 = PR_LW(jn_ + 6, vob_); nb7 = PR_LW(jn_ + 7, vob_); \
      const float* ab = (ACT) + j0 * PR_TOK + th * PR_H;                                             \
      PR_STEP2(0, ca0, cb0, ACCA, ACCB) PR_STEP2(1, ca1, cb1, ACCA, ACCB) PR_STEP2(2, ca2, cb2, ACCA, ACCB)     \
      PR_STEP2(3, ca3, cb3, ACCA, ACCB) PR_STEP2(4, ca4, cb4, ACCA, ACCB) PR_STEP2(5, ca5, cb5, ACCA, ACCB)     \
      PR_STEP2(6, ca6, cb6, ACCA, ACCB) PR_STEP2(7, ca7, cb7, ACCA, ACCB)                            \
    }                                                                                                \
  }
#define PR_EPI3(C, COFF, AACC, SCU)                                                                               \
  {                                                                                                               \
    const int c = (C);                                                                                            \
    const float a0v = p.a0[c], kkv = p.k_k[c], kav = p.k_a[c], rkv = p.r_k[c];                                    \
    const float mur = p.shift_mu[c], muk = p.shift_mu[512 + c], muv = p.shift_mu[1024 + c];                       \
    const float* pu = p.P + (size_t)(t0 + th * PR_H) * N_IN + (COFF);                                 \
    const bool first = ((t0 + th * PR_H) & (SEQ - 1)) == 0;                                                       \
    const float* pm = first ? pu : pu - N_IN;                                                                     \
    const float q0r = pm[tidu], q0k = (pm + 512)[tidu], q0v = (pm + 1024)[tidu];                                  \
    float qr = first ? 0.f : q0r, qk = first ? 0.f : q0k, qv = first ? 0.f : q0v;                                 \
    _Pragma("unroll") for (int g8 = 0; g8 < PR_H; g8 += 8) {                                                      \
      float cr[8], ck[8], cvv[8];                                                                                 \
      _Pragma("unroll") for (int u = 0; u < 8; ++u) {                                                             \
        const float* ru = pu + (size_t)(g8 + u) * N_IN;                                                           \
        cr[u] = ru[tidu]; ck[u] = (ru + 512)[tidu]; cvv[u] = (ru + 1024)[tidu];                                   \
      }                                                                                                           \
      _Pragma("unroll") for (int u = 0; u < 8; ++u) {                                                             \
        const int i = g8 + u;                                                                                     \
        const float pr = cr[u] + mur * (qr - cr[u]), pk = ck[u] + muk * (qk - ck[u]), pv = cvv[u] + muv * (qv - cvv[u]); \
        qr = cr[u]; qk = ck[u]; qv = cvv[u];                                                                      \
        const float a = sigmoidf_(a0v + AACC[i]);                                                                 \
        const float kkr = pk * kkv;                                                                               \
        const float ss = wave_sum(kkr * kkr);                                                                     \
        const float kk = kkr * __builtin_amdgcn_rsqf(fmaxf(ss, 1e-24f));         \
        const float k = pk * (1.f + (a - 1.f) * kav);                                                             \
        const float bonus = wave_sum(pr * k * rkv);                                                               \
        float* su = (SCU) + (size_t)(th * PR_H + i) * 384;                                                        \
        (su + 64)[nlo] = -kk;                                                                                     \
        (su + 128)[nlo] = kk * a;                                                                                 \
        (su + 192)[nlo] = k;                                                                                      \
        (su + 256)[nlo] = pr;                                                                                     \
        (su + 320)[nlo] = pv;                                                                                     \
        (p.BV + (size_t)(t0 + th * PR_H + i) * 512 + (COFF))[tidu] = bonus * pv;                                  \
        if ((i & 1) == 1) __builtin_amdgcn_sched_barrier(0);                                                      \
      }                                                                                                           \
    }                                                                                                             \
  }
    for (int th = 0; th < 2; ++th) {
      {
        float gA[PR_H], gB[PR_H];
#pragma unroll
        for (int i = 0; i < PR_H; ++i) { gA[i] = 0.f; gB[i] = 0.f; }
        PR_PASS2(128, g2, actg, gA, gB)
#pragma unroll
        for (int i = 0; i < PR_H; ++i) {
          float* gu = p.G + (size_t)(t0 + th * PR_H + i) * 512;
          gu[tidu] = gA[i];
          (gu + 256)[tidu] = gB[i];
        }
      }
      {
        float wA[PR_H], wB[PR_H];
#pragma unroll
        for (int i = 0; i < PR_H; ++i) { wA[i] = 0.f; wB[i] = 0.f; }
        PR_PASS2(64, w2, actw, wA, wB)
        const float w0a = p.w0[c0], w0b = p.w0[c1];
#pragma unroll
        for (int i = 0; i < PR_H; ++i) {
          (scuA + (size_t)(th * PR_H + i) * 384)[nlo] = fexp(-fexp(-fsoftplus(-(w0a + wA[i])) - 0.5f));
          (scuB + (size_t)(th * PR_H + i) * 384)[nlo] = fexp(-fexp(-fsoftplus(-(w0b + wB[i])) - 0.5f));
          if ((i & 3) == 3) __builtin_amdgcn_sched_barrier(0);
        }
      }
      {
        float aA[PR_H], aB[PR_H];
#pragma unroll
        for (int i = 0; i < PR_H; ++i) { aA[i] = 0.f; aB[i] = 0.f; }
        PR_PASS2(64, a2, acta, aA, aB)
        PR_EPI3(c0, 0, aA, scuA)
        PR_EPI3(c1, 256, aB, scuB)
      }
    }
#undef PR_EPI3
#undef PR_PASS2
#undef PR_LW
#undef PR_STEP2
#undef PR_H
  }
}

__device__ __forceinline__ void phase_prep_dsa(const Params& p, int bid, int nb, float* sm) {
  const int tid = fresh_tid(), lane = tid & 63, wv = tid >> 6;
  for (int item = bid; item < T_TOK / 4; item += nb) {
    const int t = item * 4 + wv;
    const float* row = p.P + (size_t)t * N_IN;
    {
      const float4 v = *(const float4*)&row[1792 + lane * 4];
      const float ms = wave_sum(v.x * v.x + v.y * v.y + v.z * v.z + v.w * v.w) * (1.f / 256.f);
      const float rs = rsqrtf(ms + 1e-6f);
      const float4 g = *(const float4*)&p.q_norm[lane * 4];
      *(uint2*)&p.QLATb[(size_t)t * 256 + lane * 4] = make_uint2(pack_bf16(v.x * rs * g.x, v.y * rs * g.y), pack_bf16(v.z * rs * g.z, v.w * rs * g.w));
    }
    {
      const float2 v = *(const float2*)&row[2048 + lane * 2];
      const float ms = wave_sum(v.x * v.x + v.y * v.y) * (1.f / 128.f);
      const float rs = rsqrtf(ms + 1e-6f);
      const float2 g = *(const float2*)&p.kv_norm[lane * 2];
      *(unsigned*)&p.CLATb[(size_t)t * 128 + lane * 2] = pack_bf16(v.x * rs * g.x, v.y * rs * g.y);
    }
    {
      const float v = row[2176 + lane];
      const float mu = wave_sum(v) * (1.f / 64.f);
      const float d = v - mu;
      const float var = wave_sum(d * d) * (1.f / 64.f);
      p.IKb[(size_t)t * 64 + lane] = to_bf16(d * rsqrtf(var + 1e-5f) * p.idx_ln_g[lane] + p.idx_ln_b[lane]);
    }
    if (lane < 8) p.IW[(size_t)t * 8 + lane] = row[2240 + lane] * 0.35355339059327373f;
  }
  (void)sm;
}

__device__ __forceinline__ void phase_qproj(const Params& p, int bid, int nb, float* smf, int nsl = 1) {
  bf16_t* sm = (bf16_t*)smf;
  MFMA_IDS
  for (int jw_ = 0;; ++jw_) {
    const int item = bid + (jw_ % nsl) + (jw_ / nsl) * nb;
    if (item >= 128 * 8) break;
    const int nt = item & 7, mt = item >> 3;
    const float* W = (nt < 4) ? p.w_q_up : p.idx_w_q;
    bf16_t* O = (nt < 4) ? p.Qb : p.IQb;
    const int n0 = (nt & 3) * 128;
    LoadRowsBF16 A;
    setup_rows(A, p.QLATb, (size_t)mt * 128 * 256, 256);
    LoadWeightKN B;
    setup_weight(B, W, (size_t)n0, 512, 127);
    f32x16 acc[2][2];
    mfma_gemm128(256, A, B, acc, sm);
#pragma unroll
    for (int mi = 0; mi < 2; ++mi)
#pragma unroll
      for (int ni = 0; ni < 2; ++ni)
#pragma unroll
        for (int q = 0; q < 16; ++q)
          O[(size_t)(mt * 128 + ACC_ROW(mi, q)) * 512 + n0 + ACC_COL(ni)] = to_bf16(acc[mi][ni][q]);
  }
}

__device__ __forceinline__ void phase_qabs(const Params& p, int bid, int nb, float* smf, int nsl = 1) {
  bf16_t* sm = (bf16_t*)smf;
  MFMA_IDS
  for (int jw_ = 0;; ++jw_) {
    const int item = bid + (jw_ % nsl) + (jw_ / nsl) * nb;
    if (item >= 128 * 8) break;
    const int h = item & 7, mt = item >> 3;
    LoadRowsBF16 A;
    setup_rows(A, p.Qb, (size_t)mt * 128 * 512 + h * 64, 512);
    LoadWeightKN B;
    setup_weight(B, p.w_uk, (size_t)h * 64 * 128, 128, 127);
    f32x16 acc[2][2];
    mfma_gemm128(64, A, B, acc, sm);
#pragma unroll
    for (int mi = 0; mi < 2; ++mi)
#pragma unroll
      for (int ni = 0; ni < 2; ++ni)
#pragma unroll
        for (int q = 0; q < 16; ++q)
          p.QABSb[(size_t)(mt * 128 + ACC_ROW(mi, q)) * 1024 + h * 128 + ACC_COL(ni)] = to_bf16(acc[mi][ni][q]);
  }
}

template <int CTRL>
__device__ __forceinline__ float dpp_add(float v) {
  return v + __builtin_bit_cast(float, __builtin_amdgcn_update_dpp(0, __builtin_bit_cast(int, v), CTRL, 0xF, 0xF, false));
}
__device__ __forceinline__ float row16_sum(float v) {
  v = dpp_add<0xB1>(v);
  v = dpp_add<0x4E>(v);
  v = dpp_add<0x141>(v);
  v = dpp_add<0x140>(v);
  return v;
}
#define SCAN_TC 16
#define SCAN_NCH (SEQ / SCAN_TC)
#define SCAN_PF_DECL(P) float4 P##a, P##b, P##c, P##d, P##e, P##f
#define SCAN_PF_LOAD(P, chunk)                                                              \
  {                                                                                         \
    const int cn_ = (chunk) < SCAN_NCH ? (chunk) : SCAN_NCH - 1;                            \
    const float4* sn_ = src + (size_t)cn_ * (SCAN_TC * 96) + tid;                           \
    P##a = sn_[0]; P##b = sn_[NTHR]; P##c = sn_[2 * NTHR]; P##d = sn_[3 * NTHR];            \
    P##e = sn_[4 * NTHR]; P##f = sn_[5 * NTHR];                                             \
  }
#define SCAN_PF_STORE(P, buf)                                                               \
  {                                                                                         \
    float4* d_ = (float4*)(buf) + tid;                                                      \
    d_[0] = P##a; d_[NTHR] = P##b; d_[2 * NTHR] = P##c; d_[3 * NTHR] = P##d;                \
    d_[4 * NTHR] = P##e; d_[5 * NTHR] = P##f;                                               \
  }
#define SCAN_CHUNK(cc, P)                                                                   \
  {                                                                                         \
    const int c_ = (cc);                                                                    \
    float* buf = sm + (c_ & 1) * SCAN_TC * 384;                                             \
    SCAN_PF_STORE(P, buf)                                                                   \
    half_bar(hb);                                                                           \
    SCAN_PF_LOAD(P, c_ + 2)                                                                 \
    if (c_ > 0) {                                                                           \
      const int st = tid >> 4, r = tid & 15;                                                \
      p.ORAW[(size_t)(b * SEQ + (c_ - 1) * SCAN_TC + st) * 512 + h * 64 + rg * 16 + r] =    \
          obuf[((c_ - 1) & 1) * 256 + st * 16 + r];                                         \
    }                                                                                       \
    scan_chunk_compute(buf, obuf + (c_ & 1) * 256, l16, row, rloc, s0, s1, s2, s3);         \
  }

struct HalfBar { volatile LAS unsigned* cnt; unsigned n; };
__device__ __forceinline__ void half_bar(HalfBar& hb) {
  hb.n += 4u;
  asm volatile("s_waitcnt lgkmcnt(0)" ::: "memory");
  if ((threadIdx.x & 63) == 0) __hip_atomic_fetch_add((LAS unsigned*)hb.cnt, 1u, __ATOMIC_RELAXED, __HIP_MEMORY_SCOPE_WORKGROUP);
  while (__hip_atomic_load((LAS unsigned*)hb.cnt, __ATOMIC_RELAXED, __HIP_MEMORY_SCOPE_WORKGROUP) < hb.n) __builtin_amdgcn_s_sleep(0);
  asm volatile("" ::: "memory");
}

__device__ __forceinline__ void scan_chunk_compute(const float* buf, float* ob, int l16, int row, int rloc, float& s0,
                                                   float& s1, float& s2, float& s3) {
  float oacc[SCAN_TC];
  const float* q0 = buf + l16 * 4;
  float4 w4 = *(const float4*)&q0[0], a4 = *(const float4*)&q0[64], b4 = *(const float4*)&q0[128],
         k4 = *(const float4*)&q0[192], r4 = *(const float4*)&q0[256];
  float vv = buf[320 + row];
#pragma unroll
  for (int st = 0; st < SCAN_TC; ++st) {
    const int sn = (st + 1 < SCAN_TC) ? st + 1 : 0;
    const float* qn = q0 + sn * 384;
    const float4 nw4 = *(const float4*)&qn[0], na4 = *(const float4*)&qn[64], nb4 = *(const float4*)&qn[128],
                 nk4 = *(const float4*)&qn[192], nr4 = *(const float4*)&qn[256];
    const float nvv = buf[sn * 384 + 320 + row];
    const float t0 = fmaf(s0, w4.x, vv * k4.x), t1 = fmaf(s1, w4.y, vv * k4.y);
    const float t2 = fmaf(s2, w4.z, vv * k4.z), t3 = fmaf(s3, w4.w, vv * k4.w);
    const float sa = row16_sum(fmaf(s0, a4.x, s1 * a4.y) + fmaf(s2, a4.z, s3 * a4.w));
    s0 = fmaf(sa, b4.x, t0);
    s1 = fmaf(sa, b4.y, t1);
    s2 = fmaf(sa, b4.z, t2);
    s3 = fmaf(sa, b4.w, t3);
    oacc[st] = row16_sum(fmaf(s0, r4.x, s1 * r4.y) + fmaf(s2, r4.z, s3 * r4.w));
    w4 = nw4; a4 = na4; b4 = nb4; k4 = nk4; r4 = nr4; vv = nvv;
  }
  if (l16 == 0) {
#pragma unroll
    for (int st = 0; st < SCAN_TC; ++st) ob[st * 16 + rloc] = oacc[st];
  }
}

__device__ __forceinline__ void scan_item(const Params& p, int item, float* sm, HalfBar& hb) {
  const int tid = fresh_tid(), lane = tid & 63, wv = tid >> 6;
  float* obuf = sm + 2 * SCAN_TC * 384;
  const int l16 = lane & 15;
  const int rloc = wv * 4 + (lane >> 4);
  const int bh = item >> 2, rg = item & 3;
  const int b = bh >> 3, h = bh & 7;
  const int row = rg * 16 + rloc;
  const float4* src = (const float4*)(p.SC + (size_t)bh * SEQ * 384);
  float s0 = 0.f, s1 = 0.f, s2 = 0.f, s3 = 0.f;
  SCAN_PF_DECL(pfA); SCAN_PF_DECL(pfB);
  SCAN_PF_LOAD(pfA, 0)
  SCAN_PF_LOAD(pfB, 1)
  half_bar(hb);
  for (int c = 0; c < SCAN_NCH; c += 2) {
    SCAN_CHUNK(c, pfA)
    SCAN_CHUNK(c + 1, pfB)
  }
  half_bar(hb);
  {
    const int st = tid >> 4, r = tid & 15;
    p.ORAW[(size_t)(b * SEQ + (SCAN_NCH - 1) * SCAN_TC + st) * 512 + h * 64 + rg * 16 + r] = obuf[((SCAN_NCH - 1) & 1) * 256 + st * 16 + r];
  }
  half_bar(hb);
}

__device__ __forceinline__ void phase_rwkv_fin(const Params& p, int bid, int nb, float* sm) {
  const int tid = fresh_tid(), lane = tid & 63, wv = tid >> 6;
  for (int item = bid; item < T_TOK * 8 / 16; item += nb) {
    const int th0 = item * 16 + wv * 4;
    float o[4], bv[4], gg[4], lw[4], lb[4];
#pragma unroll
    for (int u = 0; u < 4; ++u) {
      const int th = th0 + u, t = th >> 3, c = (th & 7) * 64 + lane;
      o[u] = p.ORAW[(size_t)t * 512 + c];
      bv[u] = p.BV[(size_t)t * 512 + c];
      gg[u] = p.G[(size_t)t * 512 + c];
      lw[u] = p.ln_w[c];
      lb[u] = p.ln_b[c];
    }
#pragma unroll
    for (int u = 0; u < 4; ++u) {
      const int th = th0 + u, t = th >> 3, c = (th & 7) * 64 + lane;
      const float mu = wave_sum(o[u]) * (1.f / 64.f);
      const float d = o[u] - mu;
      const float var = wave_sum(d * d) * (1.f / 64.f);
      p.OCATb[(size_t)t * 1024 + c] = to_bf16((d * rsqrtf(var + 64e-5f) * lw[u] + lb[u] + bv[u]) * gg[u]);
    }
  }
  (void)sm;
}

__device__ __forceinline__ void phase_scores(const Params& p, int bid, int nb, float* smf, int nsl = 1) {
  bf16_t* sm = (bf16_t*)smf;
  float* iws = smf + 10240;
  MFMA_IDS
  for (int jw_ = 0;; ++jw_) {
    const int item = bid + (jw_ % nsl) + (jw_ / nsl) * nb;
    if (item >= 8 * 136) break;
    const int b = item / 136, pidx = item % 136;
    int tt = 0;
    while ((tt + 1) * (tt + 2) / 2 <= pidx) ++tt;
    const int st = pidx - tt * (tt + 1) / 2;
    __syncthreads();
    for (int i = tid; i < 1024; i += NTHR) iws[i] = p.IW[(size_t)(b * SEQ + tt * 128) * 8 + i];
    f32x16 sc[2][2];
#pragma unroll
    for (int i = 0; i < 2; ++i)
#pragma unroll
      for (int j = 0; j < 2; ++j)
#pragma unroll
        for (int q = 0; q < 16; ++q) sc[i][j][q] = 0.f;
    LoadRowsBF16 B;
    setup_rows(B, p.IKb, (size_t)(b * SEQ + st * 128) * 64, 64);
    LoadRowsBF16 A;
    setup_rows(A, p.IQb, (size_t)(b * SEQ + tt * 128) * 512, 512);
    f32x16 acc[2][2];
    auto step = [&](int it, f32x16 (&a)[2][2]) {
      if (it & 1) {
        const int h = it >> 1;
#pragma unroll
        for (int mi = 0; mi < 2; ++mi)
#pragma unroll
          for (int q = 0; q < 16; ++q) {
            const float w = iws[ACC_ROW(mi, q) * 8 + h];
            sc[mi][0][q] += w * fmaxf(a[mi][0][q] * 0.125f, 0.f);
            sc[mi][1][q] += w * fmaxf(a[mi][1][q] * 0.125f, 0.f);
            a[mi][0][q] = 0.f;
            a[mi][1][q] = 0.f;
          }
      }
    };
    mfma_gemm128(512, A, B, acc, sm, 0, 63, step);
#pragma unroll
    for (int mi = 0; mi < 2; ++mi)
#pragma unroll
      for (int ni = 0; ni < 2; ++ni)
#pragma unroll
        for (int q = 0; q < 16; ++q)
          p.SCORES[((size_t)(b * SEQ + tt * 128 + ACC_ROW(mi, q))) * SEQ + st * 128 + ACC_COL(ni)] = sc[mi][ni][q];
  }
}

__device__ __forceinline__ unsigned fkey(float f) {
  if (f == 0.f) f = 0.f;
  const unsigned u = __float_as_uint(f);
  return (u & 0x80000000u) ? ~u : (u | 0x80000000u);
}
template <int CTRL, int ROWMASK>
__device__ __forceinline__ int dpp_addi(int v) {
  return v + __builtin_amdgcn_update_dpp(0, v, CTRL, ROWMASK, 0xF, false);
}
__device__ __forceinline__ int wave_incl_scan(int v) {
  v = dpp_addi<0x111, 0xF>(v);
  v = dpp_addi<0x112, 0xF>(v);
  v = dpp_addi<0x114, 0xF>(v);
  v = dpp_addi<0x118, 0xF>(v);
  v = dpp_addi<0x142, 0xA>(v);
  v = dpp_addi<0x143, 0xC>(v);
  return v;
}
__device__ __forceinline__ void phase_topk(const Params& p, int bid, int nb, float* sm, int nsl = 1) {
  const int tid = fresh_tid(), lane = tid & 63, wv = tid >> 6;
  int* hist = (int*)sm + 10240 + wv * 256;
  float nraw[32];
  {
    const int q0 = bid * 4 + wv, t0 = q0 & (SEQ - 1);
    const float* r0 = p.SCORES + (size_t)(q0 < T_TOK ? q0 : 0) * SEQ;
#pragma unroll
    for (int i = 0; i < 32; ++i) { const int s = i * 64 + lane; nraw[i] = r0[s <= t0 ? s : t0]; }
  }
  for (int jw_ = 0;; ++jw_) {
    const int item = bid + (jw_ % nsl) + (jw_ / nsl) * nb;
    if (item >= T_TOK / 4) break;
    const int q = item * 4 + wv;
    const int t = q & (SEQ - 1);
    int* sel = p.SEL + (size_t)q * 256;
    unsigned key[32];
#pragma unroll
    for (int i = 0; i < 32; ++i) key[i] = ((i * 64 + lane) <= t) ? fkey(nraw[i]) : 0u;
    {
      const int itn = bid + ((jw_ + 1) % nsl) + ((jw_ + 1) / nsl) * nb;
      const int qn = (itn < T_TOK / 4) ? itn * 4 + wv : q;
      const int tn = qn & (SEQ - 1);
      const float* rn = p.SCORES + (size_t)qn * SEQ;
#pragma unroll
      for (int i = 0; i < 32; ++i) { const int s = i * 64 + lane; nraw[i] = rn[s <= tn ? s : tn]; }
    }
    if (t < 256) {
      for (int j = lane; j <= t; j += 64) sel[j] = j;
      continue;
    }
    unsigned prefix = 0;
    int rem = 256;
#pragma unroll
    for (int pass = 0; pass < 4; ++pass) {
      const int shift = 24 - 8 * pass;
      *(int4*)&hist[lane * 4] = make_int4(0, 0, 0, 0);
      asm volatile("s_waitcnt lgkmcnt(0)" ::: "memory");
#pragma unroll
      for (int i = 0; i < 32; ++i) {
        const bool valid = (i * 64 + lane) <= t;
        const bool match = valid && (pass == 0 || (key[i] >> (shift + 8)) == prefix);
        if (match) atomicAdd(&hist[(key[i] >> shift) & 255u], 1);
      }
      asm volatile("s_waitcnt lgkmcnt(0)" ::: "memory");
      const int4 hv = *(const int4*)&hist[252 - 4 * lane];
      const int tot = hv.x + hv.y + hv.z + hv.w;
      const int incl = wave_incl_scan(tot);
      const int excl = incl - tot;
      const bool mine = (excl < rem) && (rem <= incl);
      int d = 0, above = 0;
      {
        int a = excl;
        if (rem <= a + hv.w) { d = 255 - 4 * lane; above = a; }
        else {
          a += hv.w;
          if (rem <= a + hv.z) { d = 254 - 4 * lane; above = a; }
          else {
            a += hv.z;
            if (rem <= a + hv.y) { d = 253 - 4 * lane; above = a; }
            else { a += hv.y; d = 252 - 4 * lane; above = a; }
          }
        }
      }
      const unsigned long long mb = __ballot(mine);
      const int src = __ffsll((long long)mb) - 1;
      d = __builtin_amdgcn_readlane(d, src);
      above = __builtin_amdgcn_readlane(above, src);
      prefix = (prefix << 8) | (unsigned)d;
      rem -= above;
    }
    const unsigned T = prefix;
    const int need = rem;
    int pos = 0, tie_seen = 0;
#pragma unroll
    for (int i = 0; i < 32; ++i) {
      const bool valid = (i * 64 + lane) <= t;
      const bool gt = valid && key[i] > T;
      const bool eq = valid && key[i] == T;
      const unsigned long long meq = __ballot(eq);
      const int eq_before = __popcll(meq & ((1ull << lane) - 1ull));
      const bool take = gt || (eq && (tie_seen + eq_before) < need);
      const unsigned long long mt = __ballot(take);
      const int before = __popcll(mt & ((1ull << lane) - 1ull));
      if (take) sel[pos + before] = i * 64 + lane;
      pos += __popcll(mt);
      tie_seen += __popcll(meq);
    }
  }
}

typedef __attribute__((ext_vector_type(4))) float f32x4_t;
typedef __attribute__((ext_vector_type(4))) short s16x4_t;
#define AT_RS 288
__device__ __forceinline__ float swz_xor16(float v) {
  return __builtin_bit_cast(float, __builtin_amdgcn_ds_swizzle(__builtin_bit_cast(int, v), 0x401F));
}
__device__ __forceinline__ void phase_attn(const Params& p, int bid, int nb, float* smf, int nsl = 1) {
  const int tid = fresh_tid(), lane = tid & 63, wv = tid >> 6;
  const int n = lane & 15, g = lane >> 4, h8 = n & 7;
  char* img = (char*)smf + wv * (32 * AT_RS + 64);
  float* alph = (float*)(img + 32 * AT_RS);
  const unsigned img_base = (unsigned)(size_t)img;
  const float slope = exp2f(-(float)(h8 + 1));
  const int q_ = n >> 2, p_ = n & 3;
#define AT_GATHER(SELP, CLP, NSELV, CH)                                                 \
  {                                                                                     \
    const int jj_ = (CH) * 32 + g;                                                      \
    const int i0 = (SELP)[jj_ + 0 < (NSELV) ? jj_ + 0 : 0], i1 = (SELP)[jj_ + 4 < (NSELV) ? jj_ + 4 : 0];      \
    const int i2 = (SELP)[jj_ + 8 < (NSELV) ? jj_ + 8 : 0], i3 = (SELP)[jj_ + 12 < (NSELV) ? jj_ + 12 : 0];    \
    const int i4 = (SELP)[jj_ + 16 < (NSELV) ? jj_ + 16 : 0], i5 = (SELP)[jj_ + 20 < (NSELV) ? jj_ + 20 : 0];  \
    const int i6 = (SELP)[jj_ + 24 < (NSELV) ? jj_ + 24 : 0], i7 = (SELP)[jj_ + 28 < (NSELV) ? jj_ + 28 : 0];  \
    gv0 = *(const uint4*)((CLP) + (size_t)i0 * 128 + n * 8); gv1 = *(const uint4*)((CLP) + (size_t)i1 * 128 + n * 8); \
    gv2 = *(const uint4*)((CLP) + (size_t)i2 * 128 + n * 8); gv3 = *(const uint4*)((CLP) + (size_t)i3 * 128 + n * 8); \
    gv4 = *(const uint4*)((CLP) + (size_t)i4 * 128 + n * 8); gv5 = *(const uint4*)((CLP) + (size_t)i5 * 128 + n * 8); \
    gv6 = *(const uint4*)((CLP) + (size_t)i6 * 128 + n * 8); gv7 = *(const uint4*)((CLP) + (size_t)i7 * 128 + n * 8); \
  }
#define AT_QFRAGS(Q, F0, F1, F2, F3)                                         \
  {                                                                          \
    const bf16_t* qp_ = p.QABSb + (size_t)(Q) * 1024 + h8 * 128 + 8 * g;     \
    F0 = *(const bf16x8_t*)(qp_); F1 = *(const bf16x8_t*)(qp_ + 32);         \
    F2 = *(const bf16x8_t*)(qp_ + 64); F3 = *(const bf16x8_t*)(qp_ + 96);    \
  }
#define AT_NSEL(Q) __builtin_amdgcn_readfirstlane((((Q) & (SEQ - 1)) < 256) ? ((Q) & (SEQ - 1)) + 1 : 256)
  uint4 gv0, gv1, gv2, gv3, gv4, gv5, gv6, gv7;
  bf16x8_t qf0, qf1, qf2, qf3;
  int nsel;
  {
    const int q0 = (bid < T_TOK / 4) ? bid * 4 + wv : 0;
    nsel = AT_NSEL(q0);
    AT_QFRAGS(q0, qf0, qf1, qf2, qf3)
    AT_GATHER(p.SEL + (size_t)q0 * 256, p.CLATb + (size_t)(q0 >> 11) * SEQ * 128, nsel, 0)
  }
  for (int jw_ = 0;; ++jw_) {
    const int item = bid + (jw_ % nsl) + (jw_ / nsl) * nb;
    if (item >= T_TOK / 4) break;
    const int q = item * 4 + wv;
    const int t = q & (SEQ - 1), b = q >> 11;
    const int nch = (nsel + 31) >> 5;
    const int* sel = p.SEL + (size_t)q * 256;
    const bf16_t* cl = p.CLATb + (size_t)b * SEQ * 128;
    const int itn = bid + ((jw_ + 1) % nsl) + ((jw_ + 1) / nsl) * nb;
    const int qn = (itn < T_TOK / 4) ? itn * 4 + wv : q;
    const int nsel_n_v = AT_NSEL(qn);
    bf16x8_t qn0, qn1, qn2, qn3;
    AT_QFRAGS(qn, qn0, qn1, qn2, qn3)
    float m_run = -1e30f, l_run = 0.f;
    f32x4_t O0 = {0.f, 0.f, 0.f, 0.f}, O1 = O0, O2 = O0, O3 = O0, O4 = O0, O5 = O0, O6 = O0, O7 = O0;
    for (int c = 0; c < nch; ++c) {
      {
        char* wr_ = img + g * AT_RS + n * 16;
        *(uint4*)(wr_ + 0 * 4 * AT_RS) = gv0; *(uint4*)(wr_ + 1 * 4 * AT_RS) = gv1; *(uint4*)(wr_ + 2 * 4 * AT_RS) = gv2;
        *(uint4*)(wr_ + 3 * 4 * AT_RS) = gv3; *(uint4*)(wr_ + 4 * 4 * AT_RS) = gv4; *(uint4*)(wr_ + 5 * 4 * AT_RS) = gv5;
        *(uint4*)(wr_ + 6 * 4 * AT_RS) = gv6; *(uint4*)(wr_ + 7 * 4 * AT_RS) = gv7;
      }
      if (c + 1 < nch) {
        AT_GATHER(sel, cl, nsel, c + 1)
      } else {
        const int nsn = __builtin_amdgcn_readfirstlane(nsel_n_v);
        AT_GATHER(p.SEL + (size_t)qn * 256, p.CLATb + (size_t)(qn >> 11) * SEQ * 128, nsn, 0)
      }
      const int jb = c * 32 + 4 * g;
      const int4 pa = *(const int4*)&sel[jb];
      const int4 pb = *(const int4*)&sel[jb + 16];
      asm volatile("s_waitcnt lgkmcnt(0)" ::: "memory");
      f32x4_t S0 = {0.f, 0.f, 0.f, 0.f}, S1 = S0;
      {
        const char* ar = img + n * AT_RS + g * 16;
        const bf16x8_t a00 = *(const bf16x8_t*)(ar), a01 = *(const bf16x8_t*)(ar + 64), a02 = *(const bf16x8_t*)(ar + 128),
                       a03 = *(const bf16x8_t*)(ar + 192);
        const char* ar1 = ar + 16 * AT_RS;
        const bf16x8_t a10 = *(const bf16x8_t*)(ar1), a11 = *(const bf16x8_t*)(ar1 + 64), a12 = *(const bf16x8_t*)(ar1 + 128),
                       a13 = *(const bf16x8_t*)(ar1 + 192);
        S0 = __builtin_amdgcn_mfma_f32_16x16x32_bf16(a00, qf0, S0, 0, 0, 0);
        S1 = __builtin_amdgcn_mfma_f32_16x16x32_bf16(a10, qf0, S1, 0, 0, 0);
        S0 = __builtin_amdgcn_mfma_f32_16x16x32_bf16(a01, qf1, S0, 0, 0, 0);
        S1 = __builtin_amdgcn_mfma_f32_16x16x32_bf16(a11, qf1, S1, 0, 0, 0);
        S0 = __builtin_amdgcn_mfma_f32_16x16x32_bf16(a02, qf2, S0, 0, 0, 0);
        S1 = __builtin_amdgcn_mfma_f32_16x16x32_bf16(a12, qf2, S1, 0, 0, 0);
        S0 = __builtin_amdgcn_mfma_f32_16x16x32_bf16(a03, qf3, S0, 0, 0, 0);
        S1 = __builtin_amdgcn_mfma_f32_16x16x32_bf16(a13, qf3, S1, 0, 0, 0);
      }
      float s0 = S0[0] * 0.125f - slope * (float)(t - pa.x), s1 = S0[1] * 0.125f - slope * (float)(t - pa.y);
      float s2 = S0[2] * 0.125f - slope * (float)(t - pa.z), s3 = S0[3] * 0.125f - slope * (float)(t - pa.w);
      float s4 = S1[0] * 0.125f - slope * (float)(t - pb.x), s5 = S1[1] * 0.125f - slope * (float)(t - pb.y);
      float s6 = S1[2] * 0.125f - slope * (float)(t - pb.z), s7 = S1[3] * 0.125f - slope * (float)(t - pb.w);
      s0 = (jb + 0 < nsel) ? s0 : -1e30f; s1 = (jb + 1 < nsel) ? s1 : -1e30f;
      s2 = (jb + 2 < nsel) ? s2 : -1e30f; s3 = (jb + 3 < nsel) ? s3 : -1e30f;
      s4 = (jb + 16 < nsel) ? s4 : -1e30f; s5 = (jb + 17 < nsel) ? s5 : -1e30f;
      s6 = (jb + 18 < nsel) ? s6 : -1e30f; s7 = (jb + 19 < nsel) ? s7 : -1e30f;
      float cm = fmaxf(fmaxf(fmaxf(s0, s1), fmaxf(s2, s3)), fmaxf(fmaxf(s4, s5), fmaxf(s6, s7)));
      cm = fmaxf(cm, swz_xor16(cm));
      cm = fmaxf(cm, __shfl_xor(cm, 32, 64));
      const float m_new = fmaxf(m_run, cm);
      const float alpha = fexp(m_run - m_new);
      m_run = m_new;
      s0 = fexp(s0 - m_new); s1 = fexp(s1 - m_new); s2 = fexp(s2 - m_new); s3 = fexp(s3 - m_new);
      s4 = fexp(s4 - m_new); s5 = fexp(s5 - m_new); s6 = fexp(s6 - m_new); s7 = fexp(s7 - m_new);
      l_run = l_run * alpha + ((s0 + s1) + (s2 + s3)) + ((s4 + s5) + (s6 + s7));
      uint4 pk;
      pk.x = pack_bf16(s0, s1); pk.y = pack_bf16(s2, s3); pk.z = pack_bf16(s4, s5); pk.w = pack_bf16(s6, s7);
      const bf16x8_t pf = __builtin_bit_cast(bf16x8_t, pk);
      if (g == 0) alph[n] = alpha;
      asm volatile("s_waitcnt lgkmcnt(0)" ::: "memory");
      const float4 al = *(const float4*)&alph[4 * (g & 1)];
      asm volatile("s_waitcnt lgkmcnt(0)" ::: "memory");
      const f32x4_t av = {al.x, al.y, al.z, al.w};
      O0 *= av; O1 *= av; O2 *= av; O3 *= av; O4 *= av; O5 *= av; O6 *= av; O7 *= av;
      const unsigned ta = img_base + (4 * g + q_) * AT_RS + 8 * p_;
      {
        s16x4_t l0, l1, l2, l3, l4, l5, l6, l7, h0, h1, h2, h3, h4, h5, h6, h7;
        asm volatile(
            "ds_read_b64_tr_b16 %0, %16\n\t"
            "ds_read_b64_tr_b16 %1, %16 offset:32\n\t"
            "ds_read_b64_tr_b16 %2, %16 offset:64\n\t"
            "ds_read_b64_tr_b16 %3, %16 offset:96\n\t"
            "ds_read_b64_tr_b16 %4, %16 offset:128\n\t"
            "ds_read_b64_tr_b16 %5, %16 offset:160\n\t"
            "ds_read_b64_tr_b16 %6, %16 offset:192\n\t"
            "ds_read_b64_tr_b16 %7, %16 offset:224\n\t"
            "ds_read_b64_tr_b16 %8, %16 offset:4608\n\t"
            "ds_read_b64_tr_b16 %9, %16 offset:4640\n\t"
            "ds_read_b64_tr_b16 %10, %16 offset:4672\n\t"
            "ds_read_b64_tr_b16 %11, %16 offset:4704\n\t"
            "ds_read_b64_tr_b16 %12, %16 offset:4736\n\t"
            "ds_read_b64_tr_b16 %13, %16 offset:4768\n\t"
            "ds_read_b64_tr_b16 %14, %16 offset:4800\n\t"
            "ds_read_b64_tr_b16 %15, %16 offset:4832\n\t"
            "s_waitcnt lgkmcnt(0)"
            : "=&v"(l0), "=&v"(l1), "=&v"(l2), "=&v"(l3), "=&v"(l4), "=&v"(l5), "=&v"(l6), "=&v"(l7), "=&v"(h0), "=&v"(h1),
              "=&v"(h2), "=&v"(h3), "=&v"(h4), "=&v"(h5), "=&v"(h6), "=&v"(h7)
            : "v"(ta)
            : "memory");
#define AT_PV(OX, LO, HI) OX = __builtin_amdgcn_mfma_f32_16x16x32_bf16(pf, __builtin_shufflevector(LO, HI, 0, 1, 2, 3, 4, 5, 6, 7), OX, 0, 0, 0);
        AT_PV(O0, l0, h0) AT_PV(O1, l1, h1) AT_PV(O2, l2, h2) AT_PV(O3, l3, h3)
        AT_PV(O4, l4, h4) AT_PV(O5, l5, h5) AT_PV(O6, l6, h6) AT_PV(O7, l7, h7)
#undef AT_PV
      }
    }
    float lt = l_run + swz_xor16(l_run);
    lt += __shfl_xor(lt, 32, 64);
    if (g == 0) alph[n] = frcp(lt);
    asm volatile("s_waitcnt lgkmcnt(0)" ::: "memory");
    const float4 il = *(const float4*)&alph[4 * (g & 1)];
    asm volatile("s_waitcnt lgkmcnt(0)" ::: "memory");
    if (g < 2) {
      bf16_t* o = p.OLATb + (size_t)q * 1024 + (4 * g) * 128 + n;
#define AT_ST(OX, CT)                                   \
  o[0 * 128 + (CT) * 16] = to_bf16(OX[0] * il.x);       \
  o[1 * 128 + (CT) * 16] = to_bf16(OX[1] * il.y);       \
  o[2 * 128 + (CT) * 16] = to_bf16(OX[2] * il.z);       \
  o[3 * 128 + (CT) * 16] = to_bf16(OX[3] * il.w);
      AT_ST(O0, 0) AT_ST(O1, 1) AT_ST(O2, 2) AT_ST(O3, 3) AT_ST(O4, 4) AT_ST(O5, 5) AT_ST(O6, 6) AT_ST(O7, 7)
    }
    nsel = __builtin_amdgcn_readfirstlane(nsel_n_v);
    qf0 = qn0; qf1 = qn1; qf2 = qn2; qf3 = qn3;
  }
}

__device__ __forceinline__ void phase_uv(const Params& p, int bid, int nb, float* smf) {
  bf16_t* sm = (bf16_t*)smf;
  MFMA_IDS
  for (int item = bid; item < 128 * 8; item += nb) {
    const int h = item & 7, mt = item >> 3;
    LoadRowsBF16 A;
    setup_rows(A, p.OLATb, (size_t)mt * 128 * 1024 + h * 128, 1024);
    LoadWeightKN B;
    setup_weight(B, p.w_uv, (size_t)h * 128 * 64, 64, 63);
    f32x16 acc[2][2];
    mfma_gemm128(128, A, B, acc, sm);
    if (wc == 0) {
#pragma unroll
      for (int mi = 0; mi < 2; ++mi)
#pragma unroll
        for (int ni = 0; ni < 2; ++ni)
#pragma unroll
          for (int q = 0; q < 16; ++q)
            p.OCATb[(size_t)(mt * 128 + ACC_ROW(mi, q)) * 1024 + 512 + h * 64 + ni * 32 + r] = to_bf16(acc[mi][ni][q]);
    }
  }
}

#define ALPHA_RES 1.189207115002721f
__device__ __forceinline__ void phase_outproj(const Params& p, int bid, int nb, float* smf) {
  bf16_t* sm = (bf16_t*)smf;
  MFMA_IDS
  for (int item = bid; item < 64 * 8; item += nb) {
    const int nt = item & 7, mt = item >> 3;
    const int bb = (mt * 256) >> 11;
    LoadRows4 A;
    setup_rows4(A, p.OCATb, (size_t)mt * 256 * 1024, 1024);
    LoadWeightKN B;
    setup_weight(B, p.w_out, (size_t)nt * 128, 1024, 127);
    f32x16 acc[4][2];
    mfma_gemm256(1024, A, B, acc, sm, 0);
    epilogue256_staged(acc, smf, [&](int row, int col, const float4& v) {
      const size_t off = (size_t)(mt * 256 + row) * 1024 + nt * 128 + col;
      const float4 xv = *(const float4*)&p.x[off];
      const float4 gt = *(const float4*)&p.mod[bb * 6144 + 2048 + nt * 128 + col];
      *(float4*)&p.Y1[off] = make_float4(ALPHA_RES * xv.x + (1.f + gt.x) * v.x, ALPHA_RES * xv.y + (1.f + gt.y) * v.y,
                                         ALPHA_RES * xv.z + (1.f + gt.z) * v.z, ALPHA_RES * xv.w + (1.f + gt.w) * v.w);
    });
  }
}


__device__ __forceinline__ void phase_ln1_router(const Params& p, int bid, int nb, float* sm) {
  const int tid = fresh_tid(), lane = tid & 63, wv = tid >> 6;
  float* us = sm;
  float* part = sm + 8192;
  float* lg = sm + 8192 + 2048;
  for (int item = bid; item < T_TOK / 8; item += nb) {
    const int t0 = item * 8;
    const int b = t0 >> 11;
    __syncthreads();
    for (int tk = wv * 2; tk < wv * 2 + 2; ++tk) {
      const int t = t0 + tk;
      float4 y[4];
#pragma unroll
      for (int i = 0; i < 4; ++i) y[i] = *(const float4*)&p.Y1[(size_t)t * 1024 + i * 256 + lane * 4];
      float sacc = 0.f;
#pragma unroll
      for (int i = 0; i < 4; ++i) sacc += y[i].x + y[i].y + y[i].z + y[i].w;
      const float mu = wave_sum(sacc) * (1.f / 1024.f);
      float vacc = 0.f;
#pragma unroll
      for (int i = 0; i < 4; ++i) {
        y[i].x -= mu; y[i].y -= mu; y[i].z -= mu; y[i].w -= mu;
        vacc += y[i].x * y[i].x + y[i].y * y[i].y + y[i].z * y[i].z + y[i].w * y[i].w;
      }
      const float rs = rsqrtf(wave_sum(vacc) * (1.f / 1024.f) + 1e-5f);
      if (lane == 0) *(float2*)&p.X1[(size_t)t * 2] = make_float2(mu, rs);
#pragma unroll
      for (int i = 0; i < 4; ++i) {
        const int k = i * 256 + lane * 4;
        const float4 g = *(const float4*)&p.ln1_g[k];
        const float4 be = *(const float4*)&p.ln1_b[k];
        const float4 x1 = make_float4(y[i].x * rs * g.x + be.x, y[i].y * rs * g.y + be.y, y[i].z * rs * g.z + be.z, y[i].w * rs * g.w + be.w);
        const float4 sh = *(const float4*)&p.mod[b * 6144 + 3072 + k];
        const float4 sc = *(const float4*)&p.mod[b * 6144 + 4096 + k];
        const float4 u2 = make_float4(x1.x * (1.f + sc.x) + sh.x, x1.y * (1.f + sc.y) + sh.y, x1.z * (1.f + sc.z) + sh.z, x1.w * (1.f + sc.w) + sh.w);
        *(uint2*)&p.U2[(size_t)t * 1024 + k] = make_uint2(pack_bf16(u2.x, u2.y), pack_bf16(u2.z, u2.w));
        us[(k + 0) * 8 + tk] = u2.x;
        us[(k + 1) * 8 + tk] = u2.y;
        us[(k + 2) * 8 + tk] = u2.z;
        us[(k + 3) * 8 + tk] = u2.w;
      }
    }
    __syncthreads();
    {
      const int e = lane & 31, kh = lane >> 5;
      const int kbeg = wv * 256 + kh * 128;
      float a0 = 0.f, a1 = 0.f, a2 = 0.f, a3 = 0.f, a4 = 0.f, a5 = 0.f, a6 = 0.f, a7 = 0.f;
      {
        const float* wp = p.w_router + kbeg * 32 + e;
        float wn0 = wp[0], wn1 = wp[32], wn2 = wp[64], wn3 = wp[96], wn4 = wp[128], wn5 = wp[160], wn6 = wp[192], wn7 = wp[224];
        for (int k0 = 0; k0 < 128; k0 += 8) {
          const float wc0 = wn0, wc1 = wn1, wc2 = wn2, wc3 = wn3, wc4 = wn4, wc5 = wn5, wc6 = wn6, wc7 = wn7;
          const float* wq = wp + ((k0 + 8 < 128) ? k0 + 8 : k0) * 32;
          wn0 = wq[0]; wn1 = wq[32]; wn2 = wq[64]; wn3 = wq[96]; wn4 = wq[128]; wn5 = wq[160]; wn6 = wq[192]; wn7 = wq[224];
          const float* ub = us + (kbeg + k0) * 8;
#define RT_STEP(KK, W)                                                                                   \
  {                                                                                                      \
    const float4 ua = *(const float4*)&ub[(KK) * 8], ubb = *(const float4*)&ub[(KK) * 8 + 4];            \
    a0 = fmaf(ua.x, W, a0); a1 = fmaf(ua.y, W, a1); a2 = fmaf(ua.z, W, a2); a3 = fmaf(ua.w, W, a3);      \
    a4 = fmaf(ubb.x, W, a4); a5 = fmaf(ubb.y, W, a5); a6 = fmaf(ubb.z, W, a6); a7 = fmaf(ubb.w, W, a7);  \
  }
          RT_STEP(0, wc0) RT_STEP(1, wc1) RT_STEP(2, wc2) RT_STEP(3, wc3) RT_STEP(4, wc4) RT_STEP(5, wc5) RT_STEP(6, wc6) RT_STEP(7, wc7)
#undef RT_STEP
        }
      }
      float* pp = part + ((wv * 2 + kh) * 8) * 32 + e;
      pp[0 * 32] = a0; pp[1 * 32] = a1; pp[2 * 32] = a2; pp[3 * 32] = a3;
      pp[4 * 32] = a4; pp[5 * 32] = a5; pp[6 * 32] = a6; pp[7 * 32] = a7;
    }
    __syncthreads();
    {
      const int tk = tid >> 5, e = tid & 31;
      float v = p.b_router[e];
#pragma unroll
      for (int i = 0; i < 8; ++i) v += part[(i * 8 + tk) * 32 + e];
      bool used = false;
      float val0 = 0.f, val1 = 0.f, val2 = 0.f, val3 = 0.f;
      int id0 = 0, id1 = 0, id2 = 0, id3 = 0;
#pragma unroll
      for (int k = 0; k < 4; ++k) {
        const float cand = used ? -3.4e38f : v;
        float m = cand;
        m = fmaxf(m, __shfl_xor(m, 1, 64));
        m = fmaxf(m, __shfl_xor(m, 2, 64));
        m = fmaxf(m, __shfl_xor(m, 4, 64));
        m = fmaxf(m, __shfl_xor(m, 8, 64));
        m = fmaxf(m, __shfl_xor(m, 16, 64));
        const unsigned long long bal = __ballot(!used && cand == m);
        const unsigned half = (unsigned)(bal >> (32 * (lane >> 5)));
        const int win = __ffs((int)half) - 1;
        if (k == 0) { val0 = m; id0 = win; }
        if (k == 1) { val1 = m; id1 = win; }
        if (k == 2) { val2 = m; id2 = win; }
        if (k == 3) { val3 = m; id3 = win; }
        if (e == win) used = true;
      }
      if (e < 4) {
        const int t = t0 + tk;
        const float e0 = 1.f, e1 = expf(val1 - val0), e2 = expf(val2 - val0), e3 = expf(val3 - val0);
        const float ssum = (e0 + e1) + (e2 + e3);
        const float mine = (e == 0) ? e0 : (e == 1) ? e1 : (e == 2) ? e2 : e3;
        const int ex = (e == 0) ? id0 : (e == 1) ? id1 : (e == 2) ? id2 : id3;
        p.pgate[t * 4 + e] = mine / ssum;
        const int pos = atomicAdd(&p.cnt[ex * CNT_STRIDE], 1);
        p.lists[ex * T_TOK + pos] = t * 4 + e;
        p.lgate[ex * T_TOK + pos] = mine / ssum;
      }
    }
  }
}

__device__ __forceinline__ void moe_meta_build(const Params& p, int* meta) {
  __syncthreads();
  if (fresh_tid() < 32) meta[fresh_tid()] = p.cnt[fresh_tid() * CNT_STRIDE];
  __syncthreads();
  if (fresh_tid() == 0) {
    int tp = 0, rp = 0;
    for (int e = 0; e < 32; ++e) {
      meta[32 + e] = tp;
      meta[64 + e] = rp;
      tp += (meta[e] + 255) >> 8;
      rp += meta[e];
    }
    meta[96] = tp;
  }
  __syncthreads();
}
__device__ __forceinline__ bool moe_item(const int* meta, int item, int ntn, int& e, int& mt, int& nt) {
  if (item >= meta[96] * ntn) return false;
  int ee = 0;
  while (ee < 31 && item >= meta[32 + ee + 1] * ntn) ++ee;
  const int tiles = (meta[ee] + 255) >> 8;
  const int loc = item - meta[32 + ee] * ntn;
  e = ee;
  nt = loc / tiles;
  mt = loc - nt * tiles;
  return true;
}
#define HS_STR 72

__device__ __forceinline__ void phase_moe(const Params& p, int vbid, int nb, float* smf) {
  bf16_t* sm = (bf16_t*)smf;
  int* meta = (int*)(smf + 15360);
  int* prs = (int*)(smf + 15360 + 128);
  float* gts = smf + 15360 + 384;
  const int tid = fresh_tid(), lane = tid & 63, wv = tid >> 6;
  const int wr = wv >> 1, wc = wv & 1, r = lane & 31, hh = lane >> 5;
  moe_meta_build(p, meta);
  const int N1 = meta[96] * 16, N2 = meta[96] * 8;
  for (int item = vbid; item < N1 + N2; item += nb) {
    int e, mt, nt;
    if (item < N1) {
      moe_item(meta, item, 16, e, mt, nt);
      e = __builtin_amdgcn_readfirstlane(e); mt = __builtin_amdgcn_readfirstlane(mt); nt = __builtin_amdgcn_readfirstlane(nt);
    const int cnt = meta[e], ebase = meta[64 + e];
    const int* lst = p.lists + e * T_TOK;
    const __amdgpu_buffer_rsrc_t hrs = make_rsrc(p.Hb);
    LoadRows4 A;
    {
      const int row0 = tid >> 2, kc = tid & 3;
      const int g0 = mt * 256 + row0;
      A.rs = make_rsrc(p.U2);
      A.off0 = (lst[g0 < cnt ? g0 : 0] >> 2) * 2048 + kc * 16;
      A.off1 = (lst[g0 + 64 < cnt ? g0 + 64 : 0] >> 2) * 2048 + kc * 16;
      A.off2 = (lst[g0 + 128 < cnt ? g0 + 128 : 0] >> 2) * 2048 + kc * 16;
      A.off3 = (lst[g0 + 192 < cnt ? g0 + 192 : 0] >> 2) * 2048 + kc * 16;
      A.o = row0 * LSTR + kc * 8;
    }
    LoadWeightKN B;
    {
      const int cl = tid & 127, kh = __builtin_amdgcn_readfirstlane(tid >> 7);
      const int hl = cl >> 1, sub = cl & 1;
      const int nl = (hl >> 5) * 64 + sub * 32 + (hl & 31);
      B.rs = make_rsrc(p.w_gu);
      B.ldb4 = 2048 * 4;
      B.soff = (int)((((size_t)e * 1024 + kh * 16) * 2048 + nt * 128) * 4);
      B.voff = cl * 4;
      B.o = nl * LSTR + kh * 16;
    }
    f32x16 acc[4][2];
    mfma_gemm256(1024, A, B, acc, sm, 0);
    const int hcol = nt * 64 + wc * 32 + r;
    const float bgate = p.b_gu[e * 2048 + 2 * hcol], bup = p.b_gu[e * 2048 + 2 * hcol + 1];
#pragma unroll
    for (int mi = 0; mi < 4; ++mi)
#pragma unroll
      for (int q = 0; q < 16; ++q) {
        const int row = wr * 128 + mi * 32 + (q & 3) + 8 * (q >> 2) + 4 * hh;
        const float g = fminf(acc[mi][0][q] + bgate, 7.f);
        const float u = fminf(fmaxf(acc[mi][1][q] + bup, -7.f), 7.f);
        const float hv = (u + 1.f) * (g * sigmoidf_(g * 1.702f));
        sm[row * HS_STR + wc * 32 + r] = to_bf16(hv);
      }
    __syncthreads();
#pragma unroll
    for (int i = 0; i < 8; ++i) {
      const int c = tid + i * NTHR, row = c >> 3, ch = c & 7;
      const int grow = mt * 256 + row;
      if (grow < cnt)
        __builtin_amdgcn_raw_buffer_store_b128(*(const u32x4_t*)&sm[row * HS_STR + ch * 8], hrs, ((ebase + grow) * 1024 + nt * 64 + ch * 8) * 2, 0, 16);
    }
    asm volatile("s_waitcnt vmcnt(0)" ::: "memory");
    __syncthreads();
    if (tid == 0) __hip_atomic_fetch_add(&p.moe_done[e * 64 + mt], 1, __ATOMIC_RELAXED, __HIP_MEMORY_SCOPE_AGENT);
    } else {
      moe_item(meta, item - N1, 8, e, mt, nt);
      e = __builtin_amdgcn_readfirstlane(e); mt = __builtin_amdgcn_readfirstlane(mt); nt = __builtin_amdgcn_readfirstlane(nt);
    const int cnt = meta[e], ebase = meta[64 + e];
    const int* lst = p.lists + e * T_TOK;
    if (tid == 0) {
      unsigned sp = 0;
      while (__hip_atomic_load(&p.moe_done[e * 64 + mt], __ATOMIC_RELAXED, __HIP_MEMORY_SCOPE_AGENT) < 16) {
        __builtin_amdgcn_s_sleep(4);
        if (++sp > (1u << 24)) break;
      }
      __builtin_amdgcn_fence(__ATOMIC_ACQUIRE, "agent");
      asm volatile("s_waitcnt vmcnt(0)" ::: "memory");
    }
    {
      const int grow = mt * 256 + tid;
      const int pr = (grow < cnt) ? lst[grow] : -1;
      prs[tid] = pr;
      gts[tid] = (pr >= 0) ? p.pgate[pr] : 0.f;
    }
    __syncthreads();
    LoadRows4 A;
    {
      const int row0 = tid >> 2, kc = tid & 3;
      const int g0 = mt * 256 + row0;
      A.rs = make_rsrc(p.Hb);
      A.off0 = (ebase + (g0 < cnt ? g0 : 0)) * 2048 + kc * 16;
      A.off1 = (ebase + (g0 + 64 < cnt ? g0 + 64 : 0)) * 2048 + kc * 16;
      A.off2 = (ebase + (g0 + 128 < cnt ? g0 + 128 : 0)) * 2048 + kc * 16;
      A.off3 = (ebase + (g0 + 192 < cnt ? g0 + 192 : 0)) * 2048 + kc * 16;
      A.o = row0 * LSTR + kc * 8;
    }
    LoadWeightKN B;
    {
      const int cl = tid & 127, kh = __builtin_amdgcn_readfirstlane(tid >> 7);
      B.rs = make_rsrc(p.w_dn);
      B.ldb4 = 1024 * 4;
      B.soff = (int)((((size_t)e * 1024 + kh * 16) * 1024 + nt * 128) * 4);
      B.voff = cl * 4;
      B.o = cl * LSTR + kh * 16;
    }
    f32x16 acc[4][2];
    mfma_gemm256(1024, A, B, acc, sm, 0);
    for (int pass = 0; pass < 2; ++pass) {
      if (wc == pass) {
#pragma unroll
        for (int mi = 0; mi < 4; ++mi)
#pragma unroll
          for (int q = 0; q < 16; ++q) {
            const int row = wr * 128 + mi * 32 + (q & 3) + 8 * (q >> 2) + 4 * hh;
            sm[row * HS_STR + r] = to_bf16(acc[mi][0][q]);
            sm[row * HS_STR + 32 + r] = to_bf16(acc[mi][1][q]);
          }
      }
      __syncthreads();
#pragma unroll
      for (int i = 0; i < 8; ++i) {
        const int c = tid + i * NTHR, row = c >> 3, ch = c & 7;
        const int grow = mt * 256 + row;
        if (grow < cnt) {
          const int pair = prs[row];
          const float gt = gts[row];
          const int col = nt * 128 + pass * 64 + ch * 8;
          const uint4 v = *(const uint4*)&sm[row * HS_STR + ch * 8];
          const float4 b0 = *(const float4*)&p.b_dn[e * 1024 + col], b1 = *(const float4*)&p.b_dn[e * 1024 + col + 4];
          uint4 o;
          o.x = pack_bf16((bf16_lo(v.x) + b0.x) * gt, (bf16_hi(v.x) + b0.y) * gt);
          o.y = pack_bf16((bf16_lo(v.y) + b0.z) * gt, (bf16_hi(v.y) + b0.w) * gt);
          o.z = pack_bf16((bf16_lo(v.z) + b1.x) * gt, (bf16_hi(v.z) + b1.y) * gt);
          o.w = pack_bf16((bf16_lo(v.w) + b1.z) * gt, (bf16_hi(v.w) + b1.w) * gt);
          *(uint4*)&p.POb[(size_t)pair * 1024 + col] = o;
        }
      }
      __syncthreads();
    }
    }
  }
}

__device__ __forceinline__ void phase_final(const Params& p, int bid, int nb, float* sm) {
  const int tid = fresh_tid(), lane = tid & 63, wv = tid >> 6;
  for (int item = bid; item < T_TOK / 4; item += nb) {
    const int t = item * 4 + wv;
    const int b = t >> 11;
    const float2 st1 = *(const float2*)&p.X1[(size_t)t * 2];
    float y[16];
#pragma unroll
    for (int i = 0; i < 4; ++i) {
      const int k = i * 256 + lane * 4;
      float4 f = make_float4(0.f, 0.f, 0.f, 0.f);
#pragma unroll
      for (int e = 0; e < 4; ++e) {
        const uint2 v = *(const uint2*)&p.POb[((size_t)t * 4 + e) * 1024 + k];
        f.x += bf16_lo(v.x); f.y += bf16_hi(v.x); f.z += bf16_lo(v.y); f.w += bf16_hi(v.y);
      }
      const float4 yv = *(const float4*)&p.Y1[(size_t)t * 1024 + k];
      const float4 g1 = *(const float4*)&p.ln1_g[k];
      const float4 b1 = *(const float4*)&p.ln1_b[k];
      const float4 x1 = make_float4((yv.x - st1.x) * st1.y * g1.x + b1.x, (yv.y - st1.x) * st1.y * g1.y + b1.y,
                                    (yv.z - st1.x) * st1.y * g1.z + b1.z, (yv.w - st1.x) * st1.y * g1.w + b1.w);
      const float4 gt = *(const float4*)&p.mod[b * 6144 + 5120 + k];
      y[i * 4 + 0] = ALPHA_RES * x1.x + (1.f + gt.x) * f.x;
      y[i * 4 + 1] = ALPHA_RES * x1.y + (1.f + gt.y) * f.y;
      y[i * 4 + 2] = ALPHA_RES * x1.z + (1.f + gt.z) * f.z;
      y[i * 4 + 3] = ALPHA_RES * x1.w + (1.f + gt.w) * f.w;
    }
    float sacc = 0.f;
#pragma unroll
    for (int i = 0; i < 16; ++i) sacc += y[i];
    const float mu = wave_sum(sacc) * (1.f / 1024.f);
    float vacc = 0.f;
#pragma unroll
    for (int i = 0; i < 16; ++i) { y[i] -= mu; vacc += y[i] * y[i]; }
    const float rs = rsqrtf(wave_sum(vacc) * (1.f / 1024.f) + 1e-5f);
#pragma unroll
    for (int i = 0; i < 4; ++i) {
      const int k = i * 256 + lane * 4;
      const float4 g = *(const float4*)&p.ln2_g[k];
      const float4 be = *(const float4*)&p.ln2_b[k];
      *(float4*)&p.out[(size_t)t * 1024 + k] = make_float4(y[i * 4 + 0] * rs * g.x + be.x, y[i * 4 + 1] * rs * g.y + be.y,
                                                            y[i * 4 + 2] * rs * g.z + be.z, y[i * 4 + 3] * rs * g.w + be.w);
    }
  }
  (void)sm;
}

#define HALF_FLOATS 16384
#define MISC_OFF (2 * HALF_FLOATS * 4)
#define TAB_OFF (MISC_OFF + 4096)
#define LDS_BYTES (TAB_OFF + 8192)
namespace pg {
typedef short bf16x8 __attribute__((ext_vector_type(8)));
typedef float f32x4 __attribute__((ext_vector_type(4)));
constexpr int BK = 64, HALF = 128, HTB = HALF * BK * 2, KD = 1024;
__device__ __forceinline__ int lds_byte(int r, int c) { const int st = (r >> 4) * 2 + (c >> 5), rr = r & 15, cc = c & 31, ob = rr * 64 + cc * 2; return st * 1024 + (ob ^ (((ob >> 9) & 1) << 5)); }
__device__ __forceinline__ void stage_rc(int b, int& R, int& C) { const int st = b / 1024, sb = b % 1024, swz = sb ^ (((sb >> 9) & 1) << 5); R = (st >> 1) * 16 + swz / 64; C = (st & 1) * 32 + (swz % 64) / 2; }
__device__ __forceinline__ int perm32(int rho) { const int n = rho >> 4, i = rho & 15; return 8 * (i >> 2) + 4 * n + (i & 3); }

template <class S_t>
__device__ __forceinline__ void stream(LAS unsigned char* lds, const S_t& S) {
  const int tid = fresh_tid512(), wid = __builtin_amdgcn_readfirstlane(tid >> 6), lane = tid & 63, wr = wid >> 2, wc = wid & 3, fr = lane & 15, fq = lane >> 4;
  constexpr int K = KD, nt = K / BK;
  unsigned voffB[2], c2 = 0;
#pragma unroll
  for (int i = 0; i < 2; ++i) { int R, C; stage_rc(tid * 16 + i * 8192, R, C); const int Rb = (R & ~31) + perm32(R & 31); voffB[i] = (unsigned)(Rb * K + C) * 2u; c2 = (unsigned)C * 2u; }
  constexpr size_t kstep = (size_t)(BK * 2);
  constexpr size_t hstep = (size_t)HALF * K * 2;
  const unsigned ldsw = (unsigned)wid * 1024u;
  LAS int* tabw = (LAS int*)(lds + TAB_OFF) + wid * 256;
  const int aoff = lds_byte(wr * 64 + fr, fq * 8), boff = lds_byte(wc * 32 + fr, fq * 8);
#define PG_SA(b, h) (((b) * 2 + (h)) * HTB)
#define PG_SB(b, h) ((4 + (b) * 2 + (h)) * HTB)
#define PG_STAGE(bufoff, gbase, voff) do { _Pragma("unroll") for (int _i = 0; _i < 2; ++_i) \
    __builtin_amdgcn_global_load_lds((const unsigned*)((const char*)(gbase) + (voff)[_i]), (LAS unsigned*)(lds + (bufoff) + ldsw + _i * 8192), 16, 0, 0); } while (0)
#define PG_STAGE_A(bufoff, gbase, raw) do { _Pragma("unroll") for (int _i = 0; _i < 2; ++_i) \
    __builtin_amdgcn_global_load_lds((const unsigned*)((const char*)(gbase) + S.a_off((raw)[_i], c2)), (LAS unsigned*)(lds + (bufoff) + ldsw + _i * 8192), 16, 0, 0); } while (0)
#define PG_LDA(dst, b, h) do { _Pragma("unroll") for (int m = 0; m < 4; ++m) _Pragma("unroll") for (int k = 0; k < 2; ++k) dst[m][k] = *(const LAS bf16x8*)(lds + PG_SA(b, h) + aoff + m * 2048 + k * 1024); } while (0)
#define PG_LDB(dst, b, h) do { _Pragma("unroll") for (int n = 0; n < 2; ++n) _Pragma("unroll") for (int k = 0; k < 2; ++k) dst[n][k] = *(const LAS bf16x8*)(lds + PG_SB(b, h) + boff + n * 2048 + k * 1024); } while (0)
#define PG_MMA(ai, bj, At, Bt) do { __builtin_amdgcn_s_setprio(1); _Pragma("unroll") for (int m = 0; m < 4; ++m) _Pragma("unroll") for (int n = 0; n < 2; ++n) _Pragma("unroll") for (int k = 0; k < 2; ++k) \
    acc[ai][bj][m][n] = __builtin_amdgcn_mfma_f32_16x16x32_bf16(Bt[n][k], At[m][k], acc[ai][bj][m][n], 0, 0, 0); __builtin_amdgcn_s_setprio(0); } while (0)
#define PG_WAIT_V(n) asm volatile("s_waitcnt vmcnt(" #n ")" ::: "memory")
#define PG_WAIT_L(n) asm volatile("s_waitcnt lgkmcnt(" #n ")" ::: "memory")
#define PG_BAR __builtin_amdgcn_s_barrier()
#define PG_SCHED __builtin_amdgcn_sched_barrier(0)
  typename S_t::Unit cur, nxt; int ui = 0;
  if (!S.next(0, cur)) return;
  f32x4 acc[2][2][4][2];
#pragma unroll
  for (int a = 0; a < 2; ++a)
#pragma unroll
    for (int b = 0; b < 2; ++b)
#pragma unroll
      for (int m = 0; m < 4; ++m)
#pragma unroll
        for (int n = 0; n < 2; ++n) acc[a][b][m][n] = (f32x4){0.f, 0.f, 0.f, 0.f};
  bf16x8 At[4][2], B0[2][2], B1[2][2];
  unsigned vA[2][2];
  const char *cA, *cB, *nAb, *nB;
  S.a_ready(cur);
  S.a_src(cur, vA, cA); cB = S.b_src(cur);
  PG_STAGE(PG_SB(0, 0), cB, voffB); PG_STAGE(PG_SB(0, 1), cB + hstep, voffB); PG_STAGE_A(PG_SA(0, 0), cA, vA[0]); PG_STAGE_A(PG_SA(0, 1), cA, vA[1]);
  if (wr == 1) PG_BAR;
  PG_WAIT_V(2); PG_BAR;
  PG_STAGE(PG_SB(1, 0), cB + kstep, voffB); PG_STAGE_A(PG_SA(1, 0), cA + kstep, vA[0]); PG_STAGE(PG_SB(1, 1), cB + hstep + kstep, voffB);
  PG_WAIT_V(6); PG_BAR;
  for (;;) {
    const bool has_next = S.next(ui + 1, nxt);
    nAb = cA; nB = has_next ? S.b_src(nxt) : cB;
    if (has_next) S.a_pre(nxt, tabw, lane);
    for (int t = 0; t < nt; t += 2) {
      const bool last = (t == nt - 2);
      const char* a1 = cA + (size_t)(t + 1) * kstep;
      const char* b2 = last ? nB : cB + (size_t)(t + 2) * kstep;
      const char* b3 = b2 + kstep;
      const char* a2 = last ? nAb : cA + (size_t)(t + 2) * kstep;
      const char* a3 = a2 + kstep;
      if (last && has_next) S.a_ready(nxt);
      PG_LDB(B0, 0, 0); PG_LDB(B1, 0, 1); PG_SCHED; PG_LDA(At, 0, 0); PG_STAGE_A(PG_SA(1, 1), a1, vA[1]);
      if (last && has_next) S.a_late(nxt, vA, tabw, lane);
      PG_WAIT_V(8); PG_WAIT_L(0); PG_BAR; PG_MMA(0, 0, At, B0); PG_MMA(0, 1, At, B1); PG_BAR; PG_SCHED;
      PG_LDA(At, 0, 1); PG_STAGE(PG_SB(0, 0), b2, voffB); PG_STAGE(PG_SB(0, 1), b2 + hstep, voffB); PG_STAGE_A(PG_SA(0, 0), a2, vA[0]);
      PG_WAIT_V(8); PG_WAIT_L(0); PG_BAR; PG_MMA(1, 0, At, B0); PG_MMA(1, 1, At, B1); PG_BAR; PG_SCHED;
      PG_LDB(B0, 1, 0); PG_LDB(B1, 1, 1); PG_SCHED; PG_LDA(At, 1, 0); PG_STAGE_A(PG_SA(0, 1), a2, vA[1]);
      PG_WAIT_V(8); PG_WAIT_L(0); PG_BAR; PG_MMA(0, 0, At, B0); PG_MMA(0, 1, At, B1); PG_BAR; PG_SCHED;
      PG_LDA(At, 1, 1); PG_STAGE(PG_SB(1, 0), b3, voffB); PG_STAGE(PG_SB(1, 1), b3 + hstep, voffB); PG_STAGE_A(PG_SA(1, 0), a3, vA[0]);
      PG_WAIT_V(8); PG_WAIT_L(0); PG_BAR; PG_MMA(1, 0, At, B0); PG_MMA(1, 1, At, B1); PG_BAR; PG_SCHED;
    }
    if (wr == 0) PG_BAR;
    S.epi(acc, cur, wr, wc, fr, fq); S.done(cur);
    if (!has_next) break;
#pragma unroll
    for (int a = 0; a < 2; ++a)
#pragma unroll
      for (int b = 0; b < 2; ++b)
#pragma unroll
        for (int m = 0; m < 4; ++m)
#pragma unroll
          for (int n = 0; n < 2; ++n) acc[a][b][m][n] = (f32x4){0.f, 0.f, 0.f, 0.f};
    cur = nxt; cA = nAb; cB = nB; ++ui;
    if (wr == 1) PG_BAR;
  }
  PG_WAIT_V(0);
  PG_BAR;
#undef PG_SA
#undef PG_SB
#undef PG_STAGE
#undef PG_STAGE_A
#undef PG_LDA
#undef PG_LDB
#undef PG_MMA
#undef PG_WAIT_V
#undef PG_WAIT_L
#undef PG_BAR
#undef PG_SCHED
}
__device__ __forceinline__ void lane_pieces(int (&R)[2], int (&C)[2]) {
#pragma unroll
  for (int i = 0; i < 2; ++i) stage_rc(fresh_tid512() * 16 + i * 8192, R[i], C[i]);
}
}
__device__ __forceinline__ void transpose_item(const float* W, int ldw, int nvalid, int k0, int n0, bf16_t* WT, int gu_map, float* scr, int lane) {
  const int nn = n0 + (lane & 31), ncl = nn < nvalid ? nn : nvalid - 1;
  const float* src = W + (size_t)(k0 + (lane >> 5)) * ldw + ncl;
#pragma unroll 8
  for (int i = 0; i < 32; ++i) scr[(2 * i + (lane >> 5)) * 33 + (lane & 31)] = src[(size_t)(2 * i) * ldw];
  asm volatile("s_waitcnt lgkmcnt(0)" ::: "memory");
  const int c = lane & 7;
#pragma unroll
  for (int j = 0; j < 4; ++j) {
    const int nl = (lane >> 3) + 8 * j, n = n0 + nl;
    const float* s = scr + (8 * c) * 33 + nl;
    uint4 o;
    o.x = pack_bf16(s[0 * 33], s[1 * 33]); o.y = pack_bf16(s[2 * 33], s[3 * 33]);
    o.z = pack_bf16(s[4 * 33], s[5 * 33]); o.w = pack_bf16(s[6 * 33], s[7 * 33]);
    const int row = gu_map ? (256 * (n >> 8) + 128 * (n & 1) + ((n >> 1) & 127)) : n;
    if (n < nvalid) *(uint4*)(WT + (size_t)row * 1024 + k0 + 8 * c) = o;
  }
  asm volatile("s_waitcnt lgkmcnt(0)" ::: "memory");
}
#define TR_I_IN (16 * 71)
#define TR_I_OUT (16 * 32)
#define TR_I_GU (32 * 16 * 64)
#define TR_I_DN (32 * 16 * 32)
__device__ __forceinline__ void phase_transpose(const Params& p, int lo, int hi, int gw, int ngw, float* scr) {
  const int lane = threadIdx.x & 63;
  for (int it = lo + gw; it < hi; it += ngw) {
    int r = it;
    if (r < TR_I_IN) { transpose_item(p.w_in, N_IN, N_IN, 64 * (r / 71), 32 * (r % 71), p.WinT, 0, scr, lane); continue; }
    r -= TR_I_IN;
    if (r < TR_I_OUT) { transpose_item(p.w_out, 1024, 1024, 64 * (r >> 5), 32 * (r & 31), p.WoutT, 0, scr, lane); continue; }
    r -= TR_I_OUT;
    if (r < TR_I_GU) {
      const int e = r >> 10, q = r & 1023;
      transpose_item(p.w_gu + (size_t)e * 1024 * 2048, 2048, 2048, 64 * (q >> 6), 32 * (q & 63), p.WguT + (size_t)e * 2048 * 1024, 1, scr, lane);
      continue;
    }
    r -= TR_I_GU;
    {
      const int e = r >> 9, q = r & 511;
      transpose_item(p.w_dn + (size_t)e * 1024 * 1024, 1024, 1024, 64 * (q >> 5), 32 * (q & 31), p.WdnT + (size_t)e * 1024 * 1024, 0, scr, lane);
    }
  }
}

struct MoeUnit { int e, mt, pn, cnt, gmt; };
__device__ __forceinline__ bool moe_decode(const volatile LAS int* meta, int L, int npn, MoeUnit& u) {
  if (L >= meta[64] * npn) return false;
  const unsigned long long mb = __ballot(L >= meta[33 + (threadIdx.x & 31)] * npn);
  const int e = __popc((unsigned)mb);
  const int cnt = meta[e], tiles = (cnt + 255) >> 8, loc = L - meta[32 + e] * npn;
  const int pn = loc / tiles, mt = loc - pn * tiles;
  u.e = __builtin_amdgcn_readfirstlane(e); u.pn = __builtin_amdgcn_readfirstlane(pn); u.mt = __builtin_amdgcn_readfirstlane(mt);
  u.cnt = __builtin_amdgcn_readfirstlane(cnt); u.gmt = __builtin_amdgcn_readfirstlane(meta[32 + e] + mt);
  return true;
}
struct MoeUp {
  typedef MoeUnit Unit;
  const Params& p; const volatile LAS int* meta; int G, c;
  __device__ __forceinline__ bool next(int i, Unit& u) const { return moe_decode(meta, i * G + c, 8, u); }
  __device__ __forceinline__ void a_src(const Unit& u, unsigned (&vo)[2][2], const char*& base) const {
    int R[2], C[2]; pg::lane_pieces(R, C);
    base = (const char*)p.U2;
    const int* lst = p.lists + u.e * T_TOK;
#pragma unroll
    for (int h = 0; h < 2; ++h)
#pragma unroll
      for (int i = 0; i < 2; ++i) {
        int g = u.mt * 256 + h * 128 + R[i];
        g = g < u.cnt ? g : u.cnt - 1;
        vo[h][i] = (unsigned)lst[g];
      }
  }
  __device__ __forceinline__ void a_pre(const Unit& u, LAS int* tabw, int) const {
    int R[2], C[2]; pg::lane_pieces(R, C);
    const int* lst = p.lists + u.e * T_TOK;
#pragma unroll
    for (int h = 0; h < 2; ++h)
#pragma unroll
      for (int i = 0; i < 2; ++i) {
        int g = u.mt * 256 + h * 128 + R[i];
        g = g < u.cnt ? g : u.cnt - 1;
        __builtin_amdgcn_global_load_lds((const unsigned*)(lst + g), (LAS unsigned*)(tabw + (h * 2 + i) * 64), 4, 0, 0);
      }
  }
  __device__ __forceinline__ void a_late(const Unit&, unsigned (&vo)[2][2], LAS int* tabw, int lane) const {
#pragma unroll
    for (int h = 0; h < 2; ++h)
#pragma unroll
      for (int i = 0; i < 2; ++i) vo[h][i] = (unsigned)tabw[(h * 2 + i) * 64 + lane];
  }
  __device__ __forceinline__ unsigned a_off(unsigned raw, unsigned c2) const {
    unsigned o, t;
    asm volatile("v_bfe_u32 %1, %2, 2, 14\n\tv_lshl_add_u32 %0, %1, 11, %3" : "=v"(o), "=&v"(t) : "v"(raw), "v"(c2));
    return o;
  }
  __device__ __forceinline__ const char* b_src(const Unit& u) const { return (const char*)p.WguT + ((size_t)(u.e * 2048 + u.pn * 256) * 1024) * 2; }
  __device__ __forceinline__ void a_ready(const Unit&) const {}
  __device__ __forceinline__ void epi(const pg::f32x4 (&acc)[2][2][4][2], const Unit& u, int wr, int wc, int fr, int fq) const {
    const int h0 = u.pn * 128 + wc * 32 + fq * 8;
    const float4* bp = (const float4*)(p.b_gu + u.e * 2048 + 2 * h0);
    const float4 f0 = bp[0], f1 = bp[1], f2 = bp[2], f3 = bp[3];
    const float bg[8] = {f0.x, f0.z, f1.x, f1.z, f2.x, f2.z, f3.x, f3.z};
    const float bu[8] = {f0.y, f0.w, f1.y, f1.w, f2.y, f2.w, f3.y, f3.w};
    const __amdgpu_buffer_rsrc_t hrs = make_rsrc(p.Hb);
#pragma unroll
    for (int ai = 0; ai < 2; ++ai)
#pragma unroll
      for (int m = 0; m < 4; ++m) {
        const int r = ai * 128 + wr * 64 + m * 16 + fr;
        float hv[8];
#pragma unroll
        for (int n = 0; n < 2; ++n)
#pragma unroll
          for (int q = 0; q < 4; ++q) {
            const float g = fminf(acc[ai][0][m][n][q] + bg[4 * n + q], 7.f);
            const float uu = fminf(fmaxf(acc[ai][1][m][n][q] + bu[4 * n + q], -7.f), 7.f);
            hv[4 * n + q] = (uu + 1.f) * (g * sigmoidf_(g * 1.702f));
          }
        u32x4_t w;
        w[0] = cvt_pk(hv[0], hv[1]); w[1] = cvt_pk(hv[2], hv[3]); w[2] = cvt_pk(hv[4], hv[5]); w[3] = cvt_pk(hv[6], hv[7]);
        if (u.mt * 256 + r < u.cnt) __builtin_amdgcn_raw_buffer_store_b128(w, hrs, ((u.gmt * 256 + r) * 1024 + h0) * 2, 0, 16);
      }
  }
  __device__ __forceinline__ void done(const Unit& u) const {
    asm volatile("s_waitcnt vmcnt(0)" ::: "memory");
    if ((threadIdx.x & 63) == 0) __hip_atomic_fetch_add(&p.moe_done[u.gmt], 1, __ATOMIC_RELAXED, __HIP_MEMORY_SCOPE_AGENT);
  }
};
struct MoeDn {
  typedef MoeUnit Unit;
  const Params& p; const volatile LAS int* meta; int G, c;
  __device__ __forceinline__ bool next(int i, Unit& u) const { return moe_decode(meta, i * G + c, 4, u); }
  __device__ __forceinline__ void a_src(const Unit& u, unsigned (&vo)[2][2], const char*& base) const {
    int R[2], C[2]; pg::lane_pieces(R, C);
    base = (const char*)p.Hb;
#pragma unroll
    for (int h = 0; h < 2; ++h)
#pragma unroll
      for (int i = 0; i < 2; ++i) vo[h][i] = (unsigned)(u.gmt * 256 + h * 128 + R[i]);
  }
  __device__ __forceinline__ void a_pre(const Unit&, LAS int*, int) const {}
  __device__ __forceinline__ void a_late(const Unit& u, unsigned (&vo)[2][2], LAS int*, int) const { const char* b; a_src(u, vo, b); }
  __device__ __forceinline__ unsigned a_off(unsigned raw, unsigned c2) const {
    unsigned o;
    asm volatile("v_lshl_add_u32 %0, %1, 11, %2" : "=v"(o) : "v"(raw), "v"(c2));
    return o;
  }
  __device__ __forceinline__ const char* b_src(const Unit& u) const { return (const char*)p.WdnT + ((size_t)(u.e * 1024 + u.pn * 256) * 1024) * 2; }
  __device__ __forceinline__ void a_ready(const Unit& u) const {
    if (threadIdx.x < 64) {
      unsigned sp = 0;
      while (__builtin_amdgcn_readfirstlane(__hip_atomic_load(&p.moe_done[u.gmt], __ATOMIC_RELAXED, __HIP_MEMORY_SCOPE_AGENT)) < 64) {
        __builtin_amdgcn_s_sleep(2);
        if (++sp > (1u << 22)) break;
      }
      __builtin_amdgcn_fence(__ATOMIC_ACQUIRE, "agent");
      asm volatile("s_waitcnt vmcnt(0)" ::: "memory");
    }
    asm volatile("" ::: "memory"); __builtin_amdgcn_s_barrier(); asm volatile("" ::: "memory");
  }
  __device__ __forceinline__ void epi(const pg::f32x4 (&acc)[2][2][4][2], const Unit& u, int wr, int wc, int fr, int fq) const {
    const int c0 = u.pn * 256 + wc * 32 + fq * 8;
    const float4* bp = (const float4*)(p.b_dn + u.e * 1024 + c0);
    const float4 b00 = bp[0], b01 = bp[1], b10 = bp[32], b11 = bp[33];
    const int* lst = p.lists + u.e * T_TOK;
    const float* lg = p.lgate + u.e * T_TOK;
    int pr[2][4]; float gt[2][4];
#pragma unroll
    for (int ai = 0; ai < 2; ++ai)
#pragma unroll
      for (int m = 0; m < 4; ++m) {
        int g = u.mt * 256 + ai * 128 + wr * 64 + m * 16 + fr;
        const bool ok = g < u.cnt;
        g = ok ? g : u.cnt - 1;
        pr[ai][m] = ok ? lst[g] : -1;
        gt[ai][m] = lg[g];
      }
#pragma unroll
    for (int ai = 0; ai < 2; ++ai)
#pragma unroll
      for (int m = 0; m < 4; ++m) {
        if (pr[ai][m] >= 0) {
          const float g = gt[ai][m];
          bf16_t* o = p.POb + (size_t)pr[ai][m] * 1024 + c0;
#pragma unroll
          for (int bj = 0; bj < 2; ++bj) {
            const float4 ba = bj ? b10 : b00, bb = bj ? b11 : b01;
            const pg::f32x4 v0 = acc[ai][bj][m][0], v1 = acc[ai][bj][m][1];
            uint4 w;
            w.x = cvt_pk((v0[0] + ba.x) * g, (v0[1] + ba.y) * g); w.y = cvt_pk((v0[2] + ba.z) * g, (v0[3] + ba.w) * g);
            w.z = cvt_pk((v1[0] + bb.x) * g, (v1[1] + bb.y) * g); w.w = cvt_pk((v1[2] + bb.z) * g, (v1[3] + bb.w) * g);
            *(uint4*)(o + bj * 128) = w;
          }
        }
      }
  }
  __device__ __forceinline__ void done(const Unit&) const {}
};
__device__ __forceinline__ void phase_moe8(const Params& p, int c, unsigned char* dl) {
  volatile LAS int* meta = (volatile LAS int*)(dl + MISC_OFF) + 64;
  __syncthreads();
  if (threadIdx.x < 32) meta[threadIdx.x] = p.cnt[threadIdx.x * CNT_STRIDE];
  __syncthreads();
  if (threadIdx.x == 0) {
    int tp = 0;
    for (int e = 0; e < 32; ++e) { meta[32 + e] = tp; tp += (meta[e] + 255) >> 8; }
    meta[64] = tp;
  }
  __syncthreads();
  const MoeUp up{p, meta, (int)gridDim.x, c};
  pg::stream(( LAS unsigned char*)dl, up);
  const MoeDn dn{p, meta, (int)gridDim.x, c};
  pg::stream((LAS unsigned char*)dl, dn);
}

#ifndef SLOT_S
#define SLOT_S 1
#define SLOT_D 3
#endif
__global__ void __launch_bounds__(2 * NTHR, 2) k_mega(Params p) {
  __shared__ __attribute__((aligned(16))) unsigned char dlds[LDS_BYTES];
  volatile LAS unsigned* misc = (volatile LAS unsigned*)(dlds + MISC_OFF);
  if (threadIdx.x < 16) misc[threadIdx.x] = 0u;
  __syncthreads();
  XcdBarrier xb = xcd_barrier_post(p.bar, misc);
  const int half = half_id();
  float* sm = (float*)dlds + half * HALF_FLOATS;
  const int bid = 2 * (int)blockIdx.x + half, nb = 2 * (int)gridDim.x;
  phase_ada(p, bid, nb, sm);
  xcd_barrier(xb);
  phase_u1(p, bid, nb);
  phase_transpose(p, 0, TR_I_IN + TR_I_OUT + TR_I_GU + TR_I_DN, (int)(blockIdx.x * 8 + (threadIdx.x >> 6)), (int)gridDim.x * 8, sm + (fresh_tid() >> 6) * 2112);
  xcd_barrier(xb);
  const int vblk = xcd_virtual_bid(xb);
  phase_win(p, bid, nb, sm);
  xcd_barrier(xb);
  phase_prep_rwkv(p, bid, nb, sm);
  phase_prep_dsa(p, bid, nb, sm);
  xcd_barrier(xb);
  phase_qproj(p, bid, nb, sm);
  xcd_barrier(xb);
  phase_qabs(p, bid, nb, sm);
  phase_scores(p, bid, nb, sm);
  xcd_barrier(xb);
  {
    const int nscan = (int)gridDim.x;
    const int nslots = (SLOT_S + SLOT_D) * nscan;
    const int slot0 = half == 0 ? SLOT_S * (int)blockIdx.x : SLOT_S * nscan + SLOT_D * (int)blockIdx.x;
    const int nsl = half == 0 ? SLOT_S : SLOT_D;
    if (half == 0) {
      HalfBar hb; hb.cnt = misc + 8; hb.n = 0u;
      __builtin_amdgcn_s_setprio(2);
      for (int item = blockIdx.x; item < 256; item += gridDim.x) scan_item(p, item, sm, hb);
      __builtin_amdgcn_s_setprio(0);
    }
#ifdef BISECT_SPLIT
    (void)slot0; (void)nslots; (void)nsl;
    xcd_barrier(xb);
    phase_topk(p, bid, nb, sm, 1);
    xcd_barrier(xb);
    phase_attn(p, bid, nb, sm, 1);
#else
    phase_topk(p, slot0, nslots, sm, nsl);
    asm volatile("s_waitcnt vmcnt(0)" ::: "memory");
    phase_attn(p, slot0, nslots, sm, nsl);
#endif
  }
  xcd_barrier(xb);
  phase_uv(p, bid, nb, sm);
  phase_rwkv_fin(p, bid, nb, sm);
  xcd_barrier(xb);
  phase_outproj(p, bid, nb, sm);
  xcd_barrier(xb);
  phase_ln1_router(p, bid, nb, sm);
  xcd_barrier(xb);
  phase_moe8(p, vblk, dlds);
  xcd_barrier(xb);
  phase_final(p, bid, nb, sm);
}

extern "C" void kernel_launch(void* const* d_in, const int* in_sizes, int n_in, void* d_out, int out_size, void* d_ws,
                              size_t ws_size, hipStream_t stream) {
  Params p{};
  const float** fp = (const float**)&p;
  for (int i = 0; i < 35; ++i) fp[i] = (const float*)d_in[i];
  p.out = (float*)d_out;
  float* w = (float*)d_ws;
  size_t off = 0;
  auto take = [&](size_t n) { float* r = w + off; off += (n + 63) & ~(size_t)63; return r; };
  p.bar = (unsigned*)take(4096);
  p.moe_done = (int*)take(32 * 64);
  p.mod = take(8 * 6144);
  p.X1 = take((size_t)T_TOK * 2);
  p.pgate = take(T_TOK * 4);
  p.lists = (int*)take(32 * T_TOK);
  p.lgate = take(32 * T_TOK);
  p.WinT = (unsigned short*)take((size_t)2304 * 512);
  p.WoutT = (unsigned short*)take((size_t)1024 * 512);
  p.WguT = (unsigned short*)take((size_t)32 * 2048 * 512);
  p.WdnT = (unsigned short*)take((size_t)32 * 1024 * 512);
  p.cnt = (int*)take(32 * 32);
  p.U2 = (unsigned short*)take((size_t)T_TOK * 512);
  const size_t early = off;
  p.P = take((size_t)T_TOK * N_IN);
  p.SC = take((size_t)T_TOK * 8 * 384);
  p.G = take((size_t)T_TOK * 512);
  p.BV = take((size_t)T_TOK * 512);
  p.IW = take((size_t)T_TOK * 8);
  p.QABS = take((size_t)T_TOK * 1024);
  p.SCORES = p.P;
  p.SEL = (int*)take((size_t)T_TOK * 256);
  p.NSEL = (int*)take(T_TOK);
  p.ORAW = take((size_t)T_TOK * 512);
  p.U1 = (unsigned short*)take((size_t)T_TOK * 512);
  p.QLATb = (unsigned short*)take((size_t)T_TOK * 128);
  p.Qb = (unsigned short*)take((size_t)T_TOK * 256);
  p.IQb = (unsigned short*)take((size_t)T_TOK * 256);
  p.IKb = (unsigned short*)take((size_t)T_TOK * 32);
  p.OCATb = (unsigned short*)take((size_t)T_TOK * 512);
  p.OLATb = (unsigned short*)take((size_t)T_TOK * 512);
  p.QABSb = (unsigned short*)take((size_t)T_TOK * 512);
  p.CLATb = (unsigned short*)take((size_t)T_TOK * 64);
  p.Y1 = p.QABS;
  p.Hb = (unsigned short*)(w + early);
  p.POb = p.Hb + (size_t)(T_TOK * 4 + 32 * 256) * 1024;
  static int grid_blocks = 0;
  if (!grid_blocks) {
    int dev = 0, cus = 0, per_cu = 0;
    (void)hipGetDevice(&dev);
    (void)hipDeviceGetAttribute(&cus, hipDeviceAttributeMultiprocessorCount, dev);
    (void)hipOccupancyMaxActiveBlocksPerMultiprocessor(&per_cu, k_mega, 2 * NTHR, 0);
    if (per_cu > 1) per_cu = 1;
    if (per_cu < 1) per_cu = 1;
    grid_blocks = cus * per_cu;
  }
  (void)hipMemsetAsync(p.bar, 0, XCD_BAR_WORDS * sizeof(unsigned), stream);
  void* args[] = {&p};
  (void)hipLaunchCooperativeKernel((void*)k_mega, dim3(grid_blocks), dim3(2 * NTHR), args, 0, stream);
}
```

```cpp
#include <hip/hip_runtime.h>
#include <hip/hip_cooperative_groups.h>
#include <stdint.h>

#define T_TOK 16384
#define SEQ 2048
#define NBATCH 8
#define DM 1024
#define N_IN 2248
#define N_SHIFT 1792
#define NTHR 256
__device__ __forceinline__ int fresh_tid() { int t = threadIdx.x & 255; asm volatile("" : "+v"(t)); return t; }
__device__ __forceinline__ int fresh_tid512() { int t = threadIdx.x; asm volatile("" : "+v"(t)); return t; }
__device__ __forceinline__ int half_id() { return __builtin_amdgcn_readfirstlane((int)(threadIdx.x >> 8)); }
#define CNT_STRIDE 32

struct Params {
  const float *x, *c, *w_ada, *b_ada, *w_in, *shift_mu, *w0, *w2, *a0, *a2, *g2, *k_k, *k_a, *r_k, *ln_w, *ln_b,
      *q_norm, *w_q_up, *kv_norm, *w_uk, *w_uv, *idx_w_q, *idx_ln_g, *idx_ln_b, *w_out, *ln1_g, *ln1_b, *w_router,
      *b_router, *w_gu, *b_gu, *w_dn, *b_dn, *ln2_g, *ln2_b;
  float* out;
  float *mod, *P, *SC, *G, *BV, *IW, *QABS, *SCORES, *ORAW, *Y1, *X1, *pgate;
  int *SEL, *NSEL, *lists, *cnt;
  unsigned* bar;
  int* moe_done;
  unsigned short *WinT, *WoutT, *WguT, *WdnT;
  float* lgate;
  unsigned short *U2, *Hb, *POb, *U1, *QLATb, *Qb, *IQb, *IKb, *OCATb, *OLATb, *QABSb, *CLATb;
};

__device__ __forceinline__ float fexp(float v) { return __builtin_amdgcn_exp2f(v * 1.4426950408889634f); }
__device__ __forceinline__ float frcp(float v) { return __builtin_amdgcn_rcpf(v); }
__device__ __forceinline__ float sigmoidf_(float v) { return frcp(1.0f + fexp(-v)); }
__device__ __forceinline__ float ftanh(float v) { return 1.0f - 2.0f * frcp(fexp(2.0f * v) + 1.0f); }
__device__ __forceinline__ float fsoftplus(float z) {
  return fmaxf(z, 0.f) + __builtin_amdgcn_logf(1.0f + fexp(-fabsf(z))) * 0.6931471805599453f;
}

template <int CTRL, int ROWMASK>
__device__ __forceinline__ float dpp_addf(float v) {
  return v + __builtin_bit_cast(float, __builtin_amdgcn_update_dpp(0, __builtin_bit_cast(int, v), CTRL, ROWMASK, 0xF, false));
}
__device__ __forceinline__ float wave_sum(float v) {
  v = dpp_addf<0x111, 0xF>(v);
  v = dpp_addf<0x112, 0xF>(v);
  v = dpp_addf<0x114, 0xF>(v);
  v = dpp_addf<0x118, 0xF>(v);
  v = dpp_addf<0x142, 0xA>(v);
  v = dpp_addf<0x143, 0xC>(v);
  return __builtin_bit_cast(float, __builtin_amdgcn_readlane(__builtin_bit_cast(int, v), 63));
}


#define XB_TMO      128
#define XB_XCNT(j)  (256  + 64 * (j))
#define XB_XSUB(j)  (1280 + 64 * (j))
#define XB_XGEN(j)  (2304 + 64 * (j))
#define XB_TOP      3328
#define XB_TOPGEN   3392
#define XCD_BAR_WORDS 3456
#define XB_SPIN_CAP (1u << 22)
#define LAS __attribute__((address_space(3)))
__device__ __forceinline__ unsigned xb_ld(unsigned* p) { return __hip_atomic_load(p, __ATOMIC_RELAXED, __HIP_MEMORY_SCOPE_AGENT); }
__device__ __forceinline__ unsigned xb_add(unsigned* p, unsigned v) { return __hip_atomic_fetch_add(p, v, __ATOMIC_RELAXED, __HIP_MEMORY_SCOPE_AGENT); }
__device__ __forceinline__ unsigned xb_xcc_id() { return (unsigned)__builtin_amdgcn_s_getreg((3 << 11) | 20) & 0xFu; }
#define XB_SPIN(cond, bar) do { unsigned _sp = 0; while (cond) { __builtin_amdgcn_s_sleep(1); \
    if ((++_sp & 255u) == 0u) { if (xb_ld(&(bar)[XB_TMO])) break; if (_sp > XB_SPIN_CAP) { atomicAdd(&(bar)[XB_TMO], 1u); break; } } } } while (0)
struct XcdBarrier { unsigned* bar; unsigned x; volatile LAS unsigned* st; };
__device__ __forceinline__ XcdBarrier xcd_barrier_post(unsigned* bar, volatile LAS unsigned* st) {
  XcdBarrier b; b.bar = bar; b.x = xb_xcc_id(); b.st = st;
  if (threadIdx.x == 0) st[2] = xb_add(&bar[XB_XCNT(b.x)], 1u);
  return b;
}
__device__ __forceinline__ void xcd_barrier_complete(unsigned* bar, unsigned x, unsigned& nloc, unsigned& nx) {
  const unsigned G = gridDim.x * gridDim.y * gridDim.z;
  unsigned sum, cnt, mine, sp = 0u;
  for (;;) {
    sum = 0u; cnt = 0u; mine = 0u;
#pragma unroll
    for (unsigned j = 0; j < 16; ++j) { const unsigned c = xb_ld(&bar[XB_XCNT(j)]); sum += c; cnt += (c > 0u) ? 1u : 0u; mine = (j == x) ? c : mine; }
    if (sum == G) break;
    __builtin_amdgcn_s_sleep(1);
    if ((++sp & 255u) == 0u) { if (xb_ld(&bar[XB_TMO])) break; if (sp > XB_SPIN_CAP) { atomicAdd(&bar[XB_TMO], 1u); break; } }
  }
  nloc = mine > 0u ? mine : 1u; nx = cnt > 0u ? cnt : 1u;
}
__device__ __forceinline__ void xcd_barrier(const XcdBarrier& b) {
  asm volatile("s_waitcnt vmcnt(0)" ::: "memory");
  __syncthreads();
  if (threadIdx.x == 0) {
    unsigned* bar = b.bar;
    __builtin_amdgcn_s_waitcnt(0);
    unsigned nloc = b.st[0], nx = b.st[1];
    if (nloc == 0u) { xcd_barrier_complete(bar, b.x, nloc, nx); b.st[0] = nloc; b.st[1] = nx; }
    const unsigned old = xb_add(&bar[XB_XSUB(b.x)], 1u);
    const unsigned gen = old / nloc;
    if (old + 1u == (gen + 1u) * nloc) {
      __builtin_amdgcn_fence(__ATOMIC_RELEASE, "agent");
      asm volatile("s_waitcnt vmcnt(0)" ::: "memory");
      const unsigned og = xb_add(&bar[XB_TOP], 1u);
      const unsigned tg = og / nx;
      if (og + 1u == (tg + 1u) * nx) xb_add(&bar[XB_TOPGEN], 1u);
      else XB_SPIN(xb_ld(&bar[XB_TOPGEN]) == tg, bar);
      __builtin_amdgcn_fence(__ATOMIC_ACQUIRE, "agent");
      xb_add(&bar[XB_XGEN(b.x)], 1u);
      asm volatile("s_waitcnt vmcnt(0)" ::: "memory");
    } else {
      XB_SPIN(xb_ld(&bar[XB_XGEN(b.x)]) == gen, bar);
      __builtin_amdgcn_fence(__ATOMIC_ACQUIRE, "agent");
      asm volatile("s_waitcnt vmcnt(0)" ::: "memory");
    }
  }
  __syncthreads();
}


__device__ __forceinline__ int xcd_virtual_bid(const XcdBarrier& b) {
  if (threadIdx.x == 0) {
    unsigned base = 0;
    for (unsigned j = 0; j < b.x; ++j) base += xb_ld(&b.bar[XB_XCNT(j)]);
    b.st[3] = base + b.st[2];
  }
  __syncthreads();
  return __builtin_amdgcn_readfirstlane((int)b.st[3]);
}


typedef __attribute__((ext_vector_type(8))) short bf16x8_t;
typedef __attribute__((ext_vector_type(16))) float f32x16;
typedef unsigned short bf16_t;
#define LSTR 40
#define STG_ELEMS (128 * LSTR)

__device__ __forceinline__ unsigned pack_bf16(float a, float b) {
  __bf16 x = (__bf16)a, y = (__bf16)b;
  return (unsigned)__builtin_bit_cast(unsigned short, x) | ((unsigned)__builtin_bit_cast(unsigned short, y) << 16);
}
__device__ __forceinline__ bf16_t to_bf16(float a) {
  __bf16 x = (__bf16)a;
  return __builtin_bit_cast(unsigned short, x);
}
typedef __attribute__((ext_vector_type(4))) unsigned u32x4_t;
__device__ __forceinline__ unsigned cvt_pk(float a, float b) {
  unsigned r;
  asm("v_cvt_pk_bf16_f32 %0, %1, %2" : "=v"(r) : "v"(a), "v"(b));
  return r;
}
__device__ __forceinline__ __amdgpu_buffer_rsrc_t make_rsrc(const void* p) {
  return __builtin_amdgcn_make_buffer_rsrc((void*)p, 0, 0x7fffffff, 0x00020000);
}
__device__ __forceinline__ float bf16_lo(unsigned u) { return __uint_as_float(u << 16); }
__device__ __forceinline__ float bf16_hi(unsigned u) { return __uint_as_float(u & 0xFFFF0000u); }

struct LoadRowsBF16 {
  __amdgpu_buffer_rsrc_t rs;
  int v0off, v1off;
  int o0, o1;
  struct Regs { u32x4_t v0, v1; };
  __device__ __forceinline__ Regs fetch(int k0) const {
    Regs r;
    r.v0 = __builtin_amdgcn_raw_buffer_load_b128(rs, v0off, k0 * 2, 0);
    r.v1 = __builtin_amdgcn_raw_buffer_load_b128(rs, v1off, k0 * 2, 0);
    return r;
  }
  __device__ __forceinline__ void commit(bf16_t* S, const Regs r) const {
    *(u32x4_t*)(S + o0) = r.v0;
    *(u32x4_t*)(S + o1) = r.v1;
  }
};
struct LoadWeightKN {
  __amdgpu_buffer_rsrc_t rs;
  int soff;
  int ldb4;
  int voff;
  int o;
  struct Regs { float v0, v1, v2, v3, v4, v5, v6, v7, v8, v9, v10, v11, v12, v13, v14, v15; };
#define LW_LD(J) __builtin_bit_cast(float, __builtin_amdgcn_raw_buffer_load_b32(rs, voff, so + (J) * ldb4, 0))
  __device__ __forceinline__ Regs fetch(int k0) const {
    Regs r;
    const int so = soff + k0 * ldb4;
    r.v0 = LW_LD(0); r.v1 = LW_LD(1); r.v2 = LW_LD(2); r.v3 = LW_LD(3); r.v4 = LW_LD(4); r.v5 = LW_LD(5); r.v6 = LW_LD(6); r.v7 = LW_LD(7);
    r.v8 = LW_LD(8); r.v9 = LW_LD(9); r.v10 = LW_LD(10); r.v11 = LW_LD(11); r.v12 = LW_LD(12); r.v13 = LW_LD(13); r.v14 = LW_LD(14); r.v15 = LW_LD(15);
    return r;
  }
#undef LW_LD
  __device__ __forceinline__ void commit(bf16_t* S, const Regs r) const {
    u32x4_t w0, w1;
    w0[0] = cvt_pk(r.v0, r.v1); w0[1] = cvt_pk(r.v2, r.v3); w0[2] = cvt_pk(r.v4, r.v5); w0[3] = cvt_pk(r.v6, r.v7);
    w1[0] = cvt_pk(r.v8, r.v9); w1[1] = cvt_pk(r.v10, r.v11); w1[2] = cvt_pk(r.v12, r.v13); w1[3] = cvt_pk(r.v14, r.v15);
    *(u32x4_t*)(S + o) = w0;
    *(u32x4_t*)(S + o + 8) = w1;
  }
};

struct NoStepFn { __device__ __forceinline__ void operator()(int, f32x16 (&)[2][2]) const {} };
template <class AL, class BL, class SF = NoStepFn>
__device__ __forceinline__ void mfma_gemm128(int K, const AL& A, const BL& B, f32x16 (&acc)[2][2], bf16_t* sm, int kstart = 0,
                                             int kmaskB = -1, const SF& step = SF()) {
  const int tid = fresh_tid(), lane = tid & 63, wv = tid >> 6;
  const int wr = wv >> 1, wc = wv & 1, r = lane & 31, hh = lane >> 5;
#pragma unroll
  for (int i = 0; i < 2; ++i)
#pragma unroll
    for (int j = 0; j < 2; ++j)
#pragma unroll
      for (int q = 0; q < 16; ++q) acc[i][j][q] = 0.f;
  __syncthreads();
  typename AL::Regs ra = A.fetch(kstart);
  typename BL::Regs rb = B.fetch(kstart & kmaskB);
  A.commit(sm, ra);
  B.commit(sm + STG_ELEMS, rb);
  __syncthreads();
  const int aoff = (wr * 64 + r) * LSTR + hh * 8;
  const int boff = (wc * 64 + r) * LSTR + hh * 8;
  const int nk = K >> 5;
  for (int it = 0; it < nk; ++it) {
    const bf16_t* As = sm + (it & 1) * 2 * STG_ELEMS;
    const bf16_t* Bs = As + STG_ELEMS;
    bf16_t* An = sm + ((it & 1) ^ 1) * 2 * STG_ELEMS;
    int kn = kstart + ((it + 1 < nk) ? (it + 1) * 32 : it * 32);
    kn = (kn >= K) ? kn - K : kn;
    ra = A.fetch(kn);
    rb = B.fetch(kn & kmaskB);
#pragma unroll
    for (int ks = 0; ks < 2; ++ks) {
      const bf16x8_t a0 = *(const bf16x8_t*)(As + aoff + ks * 16);
      const bf16x8_t a1 = *(const bf16x8_t*)(As + aoff + 32 * LSTR + ks * 16);
      const bf16x8_t b0 = *(const bf16x8_t*)(Bs + boff + ks * 16);
      const bf16x8_t b1 = *(const bf16x8_t*)(Bs + boff + 32 * LSTR + ks * 16);
      acc[0][0] = __builtin_amdgcn_mfma_f32_32x32x16_bf16(a0, b0, acc[0][0], 0, 0, 0);
      acc[0][1] = __builtin_amdgcn_mfma_f32_32x32x16_bf16(a0, b1, acc[0][1], 0, 0, 0);
      acc[1][0] = __builtin_amdgcn_mfma_f32_32x32x16_bf16(a1, b0, acc[1][0], 0, 0, 0);
      acc[1][1] = __builtin_amdgcn_mfma_f32_32x32x16_bf16(a1, b1, acc[1][1], 0, 0, 0);
    }
    step(it, acc);
    if (it + 1 < nk) {
      A.commit(An, ra);
      B.commit(An + STG_ELEMS, rb);
    }
    __syncthreads();
  }
}

#define STG2_ELEMS ((256 + 128) * LSTR)
struct LoadRows4 {
  __amdgpu_buffer_rsrc_t rs;
  int off0, off1, off2, off3;
  int o;
  struct Regs { u32x4_t v0, v1, v2, v3; };
  __device__ __forceinline__ Regs fetch(int k0) const {
    Regs r;
    r.v0 = __builtin_amdgcn_raw_buffer_load_b128(rs, off0, k0 * 2, 0);
    r.v1 = __builtin_amdgcn_raw_buffer_load_b128(rs, off1, k0 * 2, 0);
    r.v2 = __builtin_amdgcn_raw_buffer_load_b128(rs, off2, k0 * 2, 0);
    r.v3 = __builtin_amdgcn_raw_buffer_load_b128(rs, off3, k0 * 2, 0);
    return r;
  }
  __device__ __forceinline__ void commit(bf16_t* S, const Regs r) const {
    *(u32x4_t*)(S + o) = r.v0;
    *(u32x4_t*)(S + o + 64 * LSTR) = r.v1;
    *(u32x4_t*)(S + o + 128 * LSTR) = r.v2;
    *(u32x4_t*)(S + o + 192 * LSTR) = r.v3;
  }
};

template <class AL, class BL>
__device__ __forceinline__ void mfma_gemm256(int K, const AL& A, const BL& B, f32x16 (&acc)[4][2], bf16_t* sm, int kstart) {
  const int tid = fresh_tid(), lane = tid & 63, wv = tid >> 6;
  const int wr = wv >> 1, wc = wv & 1, r = lane & 31, hh = lane >> 5;
#pragma unroll
  for (int i = 0; i < 4; ++i)
#pragma unroll
    for (int j = 0; j < 2; ++j)
#pragma unroll
      for (int q = 0; q < 16; ++q) acc[i][j][q] = 0.f;
  __syncthreads();
  typename AL::Regs ra = A.fetch(kstart);
  typename BL::Regs rb = B.fetch(kstart);
  A.commit(sm, ra);
  B.commit(sm + 256 * LSTR, rb);
  __syncthreads();
  const int aoff = (wr * 128 + r) * LSTR + hh * 8;
  const int boff = (256 + wc * 64 + r) * LSTR + hh * 8;
  const int nk = K >> 5;
  for (int it = 0; it < nk; ++it) {
    const bf16_t* S = sm + (it & 1) * STG2_ELEMS;
    bf16_t* Sn = sm + ((it & 1) ^ 1) * STG2_ELEMS;
    int kn = kstart + ((it + 1 < nk) ? (it + 1) * 32 : it * 32);
    kn = (kn >= K) ? kn - K : kn;
    ra = A.fetch(kn);
    rb = B.fetch(kn);
#pragma unroll
    for (int ks = 0; ks < 2; ++ks) {
      const bf16x8_t b0 = *(const bf16x8_t*)(S + boff + ks * 16);
      const bf16x8_t b1 = *(const bf16x8_t*)(S + boff + 32 * LSTR + ks * 16);
#pragma unroll
      for (int mi = 0; mi < 4; ++mi) {
        const bf16x8_t a = *(const bf16x8_t*)(S + aoff + mi * 32 * LSTR + ks * 16);
        acc[mi][0] = __builtin_amdgcn_mfma_f32_32x32x16_bf16(a, b0, acc[mi][0], 0, 0, 0);
        acc[mi][1] = __builtin_amdgcn_mfma_f32_32x32x16_bf16(a, b1, acc[mi][1], 0, 0, 0);
      }
    }
    if (it + 1 < nk) {
      A.commit(Sn, ra);
      B.commit(Sn + 256 * LSTR, rb);
    }
    __syncthreads();
  }
}


__device__ __forceinline__ void phase_ada(const Params& p, int bid, int nb, float* sm) {
  const int tid = fresh_tid();
  float* cact = sm;
  float* red = sm + 8192;
  if (bid == 0 && tid < 32) p.cnt[tid * CNT_STRIDE] = 0;
  if (bid == 2) for (int i = tid; i < 32 * 64; i += NTHR) p.moe_done[i] = 0;
  for (int i = tid; i < 8192; i += NTHR) {
    const float v = p.c[i];
    cact[(i & 1023) * 8 + (i >> 10)] = v / (1.0f + expf(-v));
  }
  __syncthreads();
  for (int item = bid; item < 384; item += nb) {
    const int cl = tid & 15, kg = tid >> 4;
    const int col = item * 16 + cl;
    float a0 = 0.f, a1 = 0.f, a2 = 0.f, a3 = 0.f, a4 = 0.f, a5 = 0.f, a6 = 0.f, a7 = 0.f;
    const float* wp = p.w_ada + (size_t)(kg * 64) * 6144 + col;
    float wn0 = wp[0 * 6144], wn1 = wp[1 * 6144], wn2 = wp[2 * 6144], wn3 = wp[3 * 6144], wn4 = wp[4 * 6144], wn5 = wp[5 * 6144],
          wn6 = wp[6 * 6144], wn7 = wp[7 * 6144];
    for (int k0 = 0; k0 < 64; k0 += 8) {
      const float wc0 = wn0, wc1 = wn1, wc2 = wn2, wc3 = wn3, wc4 = wn4, wc5 = wn5, wc6 = wn6, wc7 = wn7;
      const float* wq = wp + (size_t)((k0 + 8 < 64) ? k0 + 8 : k0) * 6144;
      wn0 = wq[0 * 6144]; wn1 = wq[1 * 6144]; wn2 = wq[2 * 6144]; wn3 = wq[3 * 6144];
      wn4 = wq[4 * 6144]; wn5 = wq[5 * 6144]; wn6 = wq[6 * 6144]; wn7 = wq[7 * 6144];
      const float* cb = cact + (kg * 64 + k0) * 8;
#define ADA_STEP(KK, W)                                                                                 \
  {                                                                                                     \
    const float4 ca = *(const float4*)&cb[(KK) * 8], cc = *(const float4*)&cb[(KK) * 8 + 4];            \
    a0 = fmaf(ca.x, W, a0); a1 = fmaf(ca.y, W, a1); a2 = fmaf(ca.z, W, a2); a3 = fmaf(ca.w, W, a3);     \
    a4 = fmaf(cc.x, W, a4); a5 = fmaf(cc.y, W, a5); a6 = fmaf(cc.z, W, a6); a7 = fmaf(cc.w, W, a7);     \
  }
      ADA_STEP(0, wc0) ADA_STEP(1, wc1) ADA_STEP(2, wc2) ADA_STEP(3, wc3) ADA_STEP(4, wc4) ADA_STEP(5, wc5) ADA_STEP(6, wc6) ADA_STEP(7, wc7)
#undef ADA_STEP
    }
    float* rp = red + kg * 128 + cl;
    rp[0 * 16] = a0; rp[1 * 16] = a1; rp[2 * 16] = a2; rp[3 * 16] = a3; rp[4 * 16] = a4; rp[5 * 16] = a5; rp[6 * 16] = a6; rp[7 * 16] = a7;
    __syncthreads();
    if (tid < 128) {
      const int b = tid >> 4, cc = tid & 15;
      float sacc = p.b_ada[item * 16 + cc];
#pragma unroll
      for (int g = 0; g < 16; ++g) sacc += red[g * 128 + b * 16 + cc];
      p.mod[b * 6144 + item * 16 + cc] = sacc;
    }
    __syncthreads();
  }
}

__device__ __forceinline__ void setup_rows(LoadRowsBF16& A, const bf16_t* arr, size_t origin, unsigned stride) {
  const int tid = fresh_tid(), row0 = tid >> 2, kc = tid & 3;
  A.rs = make_rsrc(arr);
  A.v0off = (int)((origin + (size_t)row0 * stride) * 2) + kc * 16;
  A.v1off = (int)((origin + (size_t)(row0 + 64) * stride) * 2) + kc * 16;
  A.o0 = row0 * LSTR + kc * 8;
  A.o1 = (row0 + 64) * LSTR + kc * 8;
}
__device__ __forceinline__ void setup_weight(LoadWeightKN& B, const float* arr, size_t origin, int ldb, int cmax) {
  const int tid = fresh_tid(), cl = tid & 127;
  const int kh = __builtin_amdgcn_readfirstlane(tid >> 7);
  B.rs = make_rsrc(arr);
  B.ldb4 = ldb * 4;
  B.soff = (int)((origin + (size_t)(kh * 16) * ldb) * 4);
  B.voff = (cl < cmax ? cl : cmax) * 4;
  B.o = cl * LSTR + kh * 16;
}
#define ACC_ROW(mi, q) (wr * 64 + (mi) * 32 + ((q) & 3) + 8 * ((q) >> 2) + 4 * hh)
#define ACC_COL(ni) (wc * 64 + (ni) * 32 + r)
#define MFMA_IDS                                              \
  const int tid = fresh_tid(), lane = tid & 63, wv = tid >> 6; \
  const int wr = wv >> 1, wc = wv & 1, r = lane & 31, hh = lane >> 5; \
  (void)tid; (void)wr; (void)wc; (void)r; (void)hh;

__device__ __forceinline__ void phase_u1(const Params& p, int bid, int nb) {
  for (size_t i = (size_t)bid * NTHR + fresh_tid(); i < (size_t)T_TOK * 128; i += (size_t)nb * NTHR) {
    const int t = (int)(i >> 7), k = (int)(i & 127) * 8;
    const float* modb = p.mod + (t >> 11) * 6144;
    const float4 x0 = *(const float4*)&p.x[(size_t)t * 1024 + k], x1 = *(const float4*)&p.x[(size_t)t * 1024 + k + 4];
    const float4 c0 = *(const float4*)&modb[1024 + k], c1 = *(const float4*)&modb[1024 + k + 4];
    const float4 h0 = *(const float4*)&modb[k], h1 = *(const float4*)&modb[k + 4];
    uint4 o;
    o.x = pack_bf16(x0.x * (1.f + c0.x) + h0.x, x0.y * (1.f + c0.y) + h0.y);
    o.y = pack_bf16(x0.z * (1.f + c0.z) + h0.z, x0.w * (1.f + c0.w) + h0.w);
    o.z = pack_bf16(x1.x * (1.f + c1.x) + h1.x, x1.y * (1.f + c1.y) + h1.y);
    o.w = pack_bf16(x1.z * (1.f + c1.z) + h1.z, x1.w * (1.f + c1.w) + h1.w);
    *(uint4*)&p.U1[(size_t)t * 1024 + k] = o;
  }
}

__device__ __forceinline__ void setup_rows4(LoadRows4& A, const bf16_t* arr, size_t origin, unsigned stride) {
  const int tid = fresh_tid(), row0 = tid >> 2, kc = tid & 3;
  A.rs = make_rsrc(arr);
  A.off0 = (int)((origin + (size_t)row0 * stride) * 2) + kc * 16;
  A.off1 = (int)((origin + (size_t)(row0 + 64) * stride) * 2) + kc * 16;
  A.off2 = (int)((origin + (size_t)(row0 + 128) * stride) * 2) + kc * 16;
  A.off3 = (int)((origin + (size_t)(row0 + 192) * stride) * 2) + kc * 16;
  A.o = row0 * LSTR + kc * 8;
}
#define ACC_ROW4(mi, q) (wr * 128 + (mi) * 32 + ((q) & 3) + 8 * ((q) >> 2) + 4 * hh)

#define EP_STR 68
template <class FN>
__device__ __forceinline__ void epilogue256_staged(const f32x16 (&acc)[4][2], float* smf, const FN& fn) {
  const int tid = fresh_tid(), lane = tid & 63, wv = tid >> 6;
  const int r = lane & 31, hh = lane >> 5;
  for (int pass = 0; pass < 4; ++pass) {
    if (wv == pass) {
#pragma unroll
      for (int mi = 0; mi < 4; ++mi)
#pragma unroll
        for (int q = 0; q < 16; ++q) {
          const int row = mi * 32 + (q & 3) + 8 * (q >> 2) + 4 * hh;
          smf[row * EP_STR + r] = acc[mi][0][q];
          smf[row * EP_STR + 32 + r] = acc[mi][1][q];
        }
    }
    __syncthreads();
    const int rh = pass >> 1, chh = pass & 1;
#pragma unroll
    for (int i = 0; i < 8; ++i) {
      const int c = tid + i * NTHR, row = c >> 4, c4 = (c & 15) * 4;
      const float4 v = *(const float4*)&smf[row * EP_STR + c4];
      fn(rh * 128 + row, chh * 64 + c4, v);
    }
    __syncthreads();
  }
}
__device__ __forceinline__ void phase_win(const Params& p, int bid, int nb, float* smf) {
  bf16_t* sm = (bf16_t*)smf;
  MFMA_IDS
  for (int item = bid; item < 64 * 18; item += nb) {
    const int nt = item % 18, mt = item / 18;
    LoadRows4 A;
    setup_rows4(A, p.U1, (size_t)mt * 256 * 1024, 1024);
    LoadWeightKN B;
    setup_weight(B, p.w_in, (size_t)nt * 128, N_IN, N_IN - 1 - nt * 128);
    f32x16 acc[4][2];
    mfma_gemm256(1024, A, B, acc, sm, 0);
    epilogue256_staged(acc, smf, [&](int row, int col, const float4& v) {
      if (nt * 128 + col < N_IN) *(float4*)&p.P[(size_t)(mt * 256 + row) * N_IN + nt * 128 + col] = v;
    });
  }
}

__device__ __forceinline__ float psh(const Params& p, int t, int s, int j) {
  const float cur = p.P[(size_t)t * N_IN + j];
  const float mu = p.shift_mu[j];
  const float pl = p.P[(size_t)(s == 0 ? t : t - 1) * N_IN + j];
  const float prev = (s == 0) ? 0.f : pl;
  return cur + mu * (prev - cur);
}

#define PR_TOK 32
#define PR_FMA4(ACC, B, V4, W)                                                                         \
  ACC[(B) + 0] = fmaf(V4.x, W, ACC[(B) + 0]); ACC[(B) + 1] = fmaf(V4.y, W, ACC[(B) + 1]);              \
  ACC[(B) + 2] = fmaf(V4.z, W, ACC[(B) + 2]); ACC[(B) + 3] = fmaf(V4.w, W, ACC[(B) + 3]);
__device__ __forceinline__ void phase_prep_rwkv(const Params& p, int bid, int nb, float* sm) {
  const int tid = fresh_tid();
  float* actw = sm;
  float* acta = sm + 64 * PR_TOK;
  float* actg = sm + 128 * PR_TOK;
  for (int item = bid; item < T_TOK / PR_TOK; item += nb) {
    const int t0 = item * PR_TOK;
    __syncthreads();
    {
      const int jj = tid;
      const float mu = p.shift_mu[1536 + jj];
      const float* pc = p.P + (size_t)t0 * N_IN + 1536 + jj;
      float prevv = ((t0 & (SEQ - 1)) == 0) ? 0.f : pc[-(ptrdiff_t)N_IN];
      for (int g8 = 0; g8 < PR_TOK; g8 += 8) {
        float cv[8];
#pragma unroll
        for (int u = 0; u < 8; ++u) cv[u] = pc[(size_t)(g8 + u) * N_IN];
#pragma unroll
        for (int u = 0; u < 8; ++u) {
          const float v = cv[u] + mu * (prevv - cv[u]);
          prevv = cv[u];
          const int tk = g8 + u;
          if (jj < 64) actw[jj * PR_TOK + tk] = ftanh(v);
          else if (jj < 128) acta[(jj - 64) * PR_TOK + tk] = v;
          else actg[(jj - 128) * PR_TOK + tk] = sigmoidf_(v);
        }
      }
    }
    __syncthreads();
    const int c0 = tid, c1 = tid + 256;
    const unsigned nlo = (unsigned)(tid & 63), tidu = (unsigned)tid;
    const int hA = __builtin_amdgcn_readfirstlane(tid >> 6);
    float* scuA = p.SC + ((size_t)(((t0 >> 11) * 8 + hA) * SEQ + (t0 & (SEQ - 1)))) * 384;
    float* scuB = scuA + (size_t)4 * SEQ * 384;
#define PR_H 16
#define PR_STEP2(JJ, WA, WB, ACCA, ACCB)                                      \
  _Pragma("unroll") for (int tq = 0; tq < PR_H / 4; ++tq) {                   \
    const float4 v4 = *(const float4*)&ab[(JJ) * PR_TOK + tq * 4];            \
    PR_FMA4(ACCA, tq * 4, v4, WA)                                             \
    PR_FMA4(ACCB, tq * 4, v4, WB)                                             \
  }
#define PR_LW(JJ, VO) __builtin_bit_cast(float, __builtin_amdgcn_raw_buffer_load_b32(wrs_, (VO), (JJ) * 2048, 0))
#define PR_PASS2(J, WARR, ACT, ACCA, ACCB)                                                           \
  {                                                                                                  \
    const __amdgpu_buffer_rsrc_t wrs_ = make_rsrc(p.WARR);   \
    const int voa_ = c0 * 4, vob_ = c1 * 4;                                                          \
    float na0 = PR_LW(0, voa_), na1 = PR_LW(1, voa_), na2 = PR_LW(2, voa_), na3 = PR_LW(3, voa_),    \
          na4 = PR_LW(4, voa_), na5 = PR_LW(5, voa_), na6 = PR_LW(6, voa_), na7 = PR_LW(7, voa_);    \
    float nb0 = PR_LW(0, vob_), nb1 = PR_LW(1, vob_), nb2 = PR_LW(2, vob_), nb3 = PR_LW(3, vob_),    \
          nb4 = PR_LW(4, vob_), nb5 = PR_LW(5, vob_), nb6 = PR_LW(6, vob_), nb7 = PR_LW(7, vob_);    \
    for (int j0 = 0; j0 < (J); j0 += 8) {                                                            \
      const float ca0 = na0, ca1 = na1, ca2 = na2, ca3 = na3, ca4 = na4, ca5 = na5, ca6 = na6, ca7 = na7;       \
      const float cb0 = nb0, cb1 = nb1, cb2 = nb2, cb3 = nb3, cb4 = nb4, cb5 = nb5, cb6 = nb6, cb7 = nb7;       \
      const int jn_ = (j0 + 8 < (J)) ? j0 + 8 : j0;                 \
      na0 = PR_LW(jn_, voa_); na1 = PR_LW(jn_ + 1, voa_); na2 = PR_LW(jn_ + 2, voa_); na3 = PR_LW(jn_ + 3, voa_);   \
      na4 = PR_LW(jn_ + 4, voa_); na5 = PR_LW(jn_ + 5, voa_); na6 = PR_LW(jn_ + 6, voa_); na7 = PR_LW(jn_ + 7, voa_); \
      nb0 = PR_LW(jn_, vob_); nb1 = PR_LW(jn_ + 1, vob_); nb2 = PR_LW(jn_ + 2, vob_); nb3 = PR_LW(jn_ + 3, vob_);   \
      nb4 = PR_LW(jn_ + 4, vob_); nb5 = PR_LW(jn_ + 5, vob_); nb6 = PR_LW(jn_ + 6, vob_); nb7 = PR_LW(jn_ + 7, vob_); \
      const float* ab = (ACT) + j0 * PR_TOK + th * PR_H;                                             \
      PR_STEP2(0, ca0, cb0, ACCA, ACCB) PR_STEP2(1, ca1, cb1, ACCA, ACCB) PR_STEP2(2, ca2, cb2, ACCA, ACCB)     \
      PR_STEP2(3, ca3, cb3, ACCA, ACCB) PR_STEP2(4, ca4, cb4, ACCA, ACCB) PR_STEP2(5, ca5, cb5, ACCA, ACCB)     \
      PR_STEP2(6, ca6, cb6, ACCA, ACCB) PR_STEP2(7, ca7, cb7, ACCA, ACCB)                            \
    }                                                                                                \
  }
#define PR_EPI3(C, COFF, AACC, SCU)                                                                               \
  {                                                                                                               \
    const int c = (C);                                                                                            \
    const float a0v = p.a0[c], kkv = p.k_k[c], kav = p.k_a[c], rkv = p.r_k[c];                                    \
    const float mur = p.shift_mu[c], muk = p.shift_mu[512 + c], muv = p.shift_mu[1024 + c];                       \
    const float* pu = p.P + (size_t)(t0 + th * PR_H) * N_IN + (COFF);                                 \
    const bool first = ((t0 + th * PR_H) & (SEQ - 1)) == 0;                                                       \
    const float* pm = first ? pu : pu - N_IN;                                                                     \
    const float q0r = pm[tidu], q0k = (pm + 512)[tidu], q0v = (pm + 1024)[tidu];                                  \
    float qr = first ? 0.f : q0r, qk = first ? 0.f : q0k, qv = first ? 0.f : q0v;                                 \
    _Pragma("unroll") for (int g8 = 0; g8 < PR_H; g8 += 8) {                                                      \
      float cr[8], ck[8], cvv[8];                                                                                 \
      _Pragma("unroll") for (int u = 0; u < 8; ++u) {                                                             \
        const float* ru = pu + (size_t)(g8 + u) * N_IN;                                                           \
        cr[u] = ru[tidu]; ck[u] = (ru + 512)[tidu]; cvv[u] = (ru + 1024)[tidu];                                   \
      }                                                                                                           \
      _Pragma("unroll") for (int u = 0; u < 8; ++u) {                                                             \
        const int i = g8 + u;                                                                                     \
        const float pr = cr[u] + mur * (qr - cr[u]), pk = ck[u] + muk * (qk - ck[u]), pv = cvv[u] + muv * (qv - cvv[u]); \
        qr = cr[u]; qk = ck[u]; qv = cvv[u];                                                                      \
        const float a = sigmoidf_(a0v + AACC[i]);                                                                 \
        const float kkr = pk * kkv;                                                                               \
        const float ss = wave_sum(kkr * kkr);                                                                     \
        const float kk = kkr * __builtin_amdgcn_rsqf(fmaxf(ss, 1e-24f));         \
        const float k = pk * (1.f + (a - 1.f) * kav);                                                             \
        const float bonus = wave_sum(pr * k * rkv);                                                               \
        float* su = (SCU) + (size_t)(th * PR_H + i) * 384;                                                        \
        (su + 64)[nlo] = -kk;                                                                                     \
        (su + 128)[nlo] = kk * a;                                                                                 \
        (su + 192)[nlo] = k;                                                                                      \
        (su + 256)[nlo] = pr;                                                                                     \
        (su + 320)[nlo] = pv;                                                                                     \
        (p.BV + (size_t)(t0 + th * PR_H + i) * 512 + (COFF))[tidu] = bonus * pv;                                  \
        if ((i & 1) == 1) __builtin_amdgcn_sched_barrier(0);                                                      \
      }                                                                                                           \
    }                                                                                                             \
  }
    for (int th = 0; th < 2; ++th) {
      {
        float gA[PR_H], gB[PR_H];
#pragma unroll
        for (int i = 0; i < PR_H; ++i) { gA[i] = 0.f; gB[i] = 0.f; }
        PR_PASS2(128, g2, actg, gA, gB)
#pragma unroll
        for (int i = 0; i < PR_H; ++i) {
          float* gu = p.G + (size_t)(t0 + th * PR_H + i) * 512;
          gu[tidu] = gA[i];
          (gu + 256)[tidu] = gB[i];
        }
      }
      {
        float wA[PR_H], wB[PR_H];
#pragma unroll
        for (int i = 0; i < PR_H; ++i) { wA[i] = 0.f; wB[i] = 0.f; }
        PR_PASS2(64, w2, actw, wA, wB)
        const float w0a = p.w0[c0], w0b = p.w0[c1];
#pragma unroll
        for (int i = 0; i < PR_H; ++i) {
          (scuA + (size_t)(th * PR_H + i) * 384)[nlo] = fexp(-fexp(-fsoftplus(-(w0a + wA[i])) - 0.5f));
          (scuB + (size_t)(th * PR_H + i) * 384)[nlo] = fexp(-fexp(-fsoftplus(-(w0b + wB[i])) - 0.5f));
          if ((i & 3) == 3) __builtin_amdgcn_sched_barrier(0);
        }
      }
      {
        float aA[PR_H], aB[PR_H];
#pragma unroll
        for (int i = 0; i < PR_H; ++i) { aA[i] = 0.f; aB[i] = 0.f; }
        PR_PASS2(64, a2, acta, aA, aB)
        PR_EPI3(c0, 0, aA, scuA)
        PR_EPI3(c1, 256, aB, scuB)
      }
    }
#undef PR_EPI3
#undef PR_PASS2
#undef PR_LW
#undef PR_STEP2
#undef PR_H
  }
}

__device__ __forceinline__ void phase_prep_dsa(const Params& p, int bid, int nb, float* sm) {
  const int tid = fresh_tid(), lane = tid & 63, wv = tid >> 6;
  for (int item = bid; item < T_TOK / 4; item += nb) {
    const int t = item * 4 + wv;
    const float* row = p.P + (size_t)t * N_IN;
    {
      const float4 v = *(const float4*)&row[1792 + lane * 4];
      const float ms = wave_sum(v.x * v.x + v.y * v.y + v.z * v.z + v.w * v.w) * (1.f / 256.f);
      const float rs = rsqrtf(ms + 1e-6f);
      const float4 g = *(const float4*)&p.q_norm[lane * 4];
      *(uint2*)&p.QLATb[(size_t)t * 256 + lane * 4] = make_uint2(pack_bf16(v.x * rs * g.x, v.y * rs * g.y), pack_bf16(v.z * rs * g.z, v.w * rs * g.w));
    }
    {
      const float2 v = *(const float2*)&row[2048 + lane * 2];
      const float ms = wave_sum(v.x * v.x + v.y * v.y) * (1.f / 128.f);
      const float rs = rsqrtf(ms + 1e-6f);
      const float2 g = *(const float2*)&p.kv_norm[lane * 2];
      *(unsigned*)&p.CLATb[(size_t)t * 128 + lane * 2] = pack_bf16(v.x * rs * g.x, v.y * rs * g.y);
    }
    {
      const float v = row[2176 + lane];
      const float mu = wave_sum(v) * (1.f / 64.f);
      const float d = v - mu;
      const float var = wave_sum(d * d) * (1.f / 64.f);
      p.IKb[(size_t)t * 64 + lane] = to_bf16(d * rsqrtf(var + 1e-5f) * p.idx_ln_g[lane] + p.idx_ln_b[lane]);
    }
    if (lane < 8) p.IW[(size_t)t * 8 + lane] = row[2240 + lane] * 0.35355339059327373f;
  }
  (void)sm;
}

__device__ __forceinline__ void phase_qproj(const Params& p, int bid, int nb, float* smf, int nsl = 1) {
  bf16_t* sm = (bf16_t*)smf;
  MFMA_IDS
  for (int jw_ = 0;; ++jw_) {
    const int item = bid + (jw_ % nsl) + (jw_ / nsl) * nb;
    if (item >= 128 * 8) break;
    const int nt = item & 7, mt = item >> 3;
    const float* W = (nt < 4) ? p.w_q_up : p.idx_w_q;
    bf16_t* O = (nt < 4) ? p.Qb : p.IQb;
    const int n0 = (nt & 3) * 128;
    LoadRowsBF16 A;
    setup_rows(A, p.QLATb, (size_t)mt * 128 * 256, 256);
    LoadWeightKN B;
    setup_weight(B, W, (size_t)n0, 512, 127);
    f32x16 acc[2][2];
    mfma_gemm128(256, A, B, acc, sm);
#pragma unroll
    for (int mi = 0; mi < 2; ++mi)
#pragma unroll
      for (int ni = 0; ni < 2; ++ni)
#pragma unroll
        for (int q = 0; q < 16; ++q)
          O[(size_t)(mt * 128 + ACC_ROW(mi, q)) * 512 + n0 + ACC_COL(ni)] = to_bf16(acc[mi][ni][q]);
  }
}

__device__ __forceinline__ void phase_qabs(const Params& p, int bid, int nb, float* smf, int nsl = 1) {
  bf16_t* sm = (bf16_t*)smf;
  MFMA_IDS
  for (int jw_ = 0;; ++jw_) {
    const int item = bid + (jw_ % nsl) + (jw_ / nsl) * nb;
    if (item >= 128 * 8) break;
    const int h = item & 7, mt = item >> 3;
    LoadRowsBF16 A;
    setup_rows(A, p.Qb, (size_t)mt * 128 * 512 + h * 64, 512);
    LoadWeightKN B;
    setup_weight(B, p.w_uk, (size_t)h * 64 * 128, 128, 127);
    f32x16 acc[2][2];
    mfma_gemm128(64, A, B, acc, sm);
#pragma unroll
    for (int mi = 0; mi < 2; ++mi)
#pragma unroll
      for (int ni = 0; ni < 2; ++ni)
#pragma unroll
        for (int q = 0; q < 16; ++q)
          p.QABSb[(size_t)(mt * 128 + ACC_ROW(mi, q)) * 1024 + h * 128 + ACC_COL(ni)] = to_bf16(acc[mi][ni][q]);
  }
}

template <int CTRL>
__device__ __forceinline__ float dpp_add(float v) {
  return v + __builtin_bit_cast(float, __builtin_amdgcn_update_dpp(0, __builtin_bit_cast(int, v), CTRL, 0xF, 0xF, false));
}
__device__ __forceinline__ float row16_sum(float v) {
  v = dpp_add<0xB1>(v);
  v = dpp_add<0x4E>(v);
  v = dpp_add<0x141>(v);
  v = dpp_add<0x140>(v);
  return v;
}
#define SCAN_TC 16
#define SCAN_NCH (SEQ / SCAN_TC)
#define SCAN_PF_DECL(P) float4 P##a, P##b, P##c, P##d, P##e, P##f
#define SCAN_PF_LOAD(P, chunk)                                                              \
  {                                                                                         \
    const int cn_ = (chunk) < SCAN_NCH ? (chunk) : SCAN_NCH - 1;                            \
    const float4* sn_ = src + (size_t)cn_ * (SCAN_TC * 96) + tid;                           \
    P##a = sn_[0]; P##b = sn_[NTHR]; P##c = sn_[2 * NTHR]; P##d = sn_[3 * NTHR];            \
    P##e = sn_[4 * NTHR]; P##f = sn_[5 * NTHR];                                             \
  }
#define SCAN_PF_STORE(P, buf)                                                               \
  {                                                                                         \
    float4* d_ = (float4*)(buf) + tid;                                                      \
    d_[0] = P##a; d_[NTHR] = P##b; d_[2 * NTHR] = P##c; d_[3 * NTHR] = P##d;                \
    d_[4 * NTHR] = P##e; d_[5 * NTHR] = P##f;                                               \
  }
#define SCAN_CHUNK(cc, P)                                                                   \
  {                                                                                         \
    const int c_ = (cc);                                                                    \
    float* buf = sm + (c_ & 1) * SCAN_TC * 384;                                             \
    SCAN_PF_STORE(P, buf)                                                                   \
    half_bar(hb);                                                                           \
    SCAN_PF_LOAD(P, c_ + 2)                                                                 \
    if (c_ > 0) {                                                                           \
      const int st = tid >> 4, r = tid & 15;                                                \
      p.ORAW[(size_t)(b * SEQ + (c_ - 1) * SCAN_TC + st) * 512 + h * 64 + rg * 16 + r] =    \
          obuf[((c_ - 1) & 1) * 256 + st * 16 + r];                                         \
    }                                                                                       \
    scan_chunk_compute(buf, obuf + (c_ & 1) * 256, l16, row, rloc, s0, s1, s2, s3);         \
  }

struct HalfBar { volatile LAS unsigned* cnt; unsigned n; };
__device__ __forceinline__ void half_bar(HalfBar& hb) {
  hb.n += 4u;
  asm volatile("s_waitcnt lgkmcnt(0)" ::: "memory");
  if ((threadIdx.x & 63) == 0) __hip_atomic_fetch_add((LAS unsigned*)hb.cnt, 1u, __ATOMIC_RELAXED, __HIP_MEMORY_SCOPE_WORKGROUP);
  while (__hip_atomic_load((LAS unsigned*)hb.cnt, __ATOMIC_RELAXED, __HIP_MEMORY_SCOPE_WORKGROUP) < hb.n) __builtin_amdgcn_s_sleep(0);
  asm volatile("" ::: "memory");
}

__device__ __forceinline__ void scan_chunk_compute(const float* buf, float* ob, int l16, int row, int rloc, float& s0,
                                                   float& s1, float& s2, float& s3) {
  float oacc[SCAN_TC];
  const float* q0 = buf + l16 * 4;
  float4 w4 = *(const float4*)&q0[0], a4 = *(const float4*)&q0[64], b4 = *(const float4*)&q0[128],
         k4 = *(const float4*)&q0[192], r4 = *(const float4*)&q0[256];
  float vv = buf[320 + row];
#pragma unroll
  for (int st = 0; st < SCAN_TC; ++st) {
    const int sn = (st + 1 < SCAN_TC) ? st + 1 : 0;
    const float* qn = q0 + sn * 384;
    const float4 nw4 = *(const float4*)&qn[0], na4 = *(const float4*)&qn[64], nb4 = *(const float4*)&qn[128],
                 nk4 = *(const float4*)&qn[192], nr4 = *(const float4*)&qn[256];
    const float nvv = buf[sn * 384 + 320 + row];
    const float t0 = fmaf(s0, w4.x, vv * k4.x), t1 = fmaf(s1, w4.y, vv * k4.y);
    const float t2 = fmaf(s2, w4.z, vv * k4.z), t3 = fmaf(s3, w4.w, vv * k4.w);
    const float sa = row16_sum(fmaf(s0, a4.x, s1 * a4.y) + fmaf(s2, a4.z, s3 * a4.w));
    s0 = fmaf(sa, b4.x, t0);
    s1 = fmaf(sa, b4.y, t1);
    s2 = fmaf(sa, b4.z, t2);
    s3 = fmaf(sa, b4.w, t3);
    oacc[st] = row16_sum(fmaf(s0, r4.x, s1 * r4.y) + fmaf(s2, r4.z, s3 * r4.w));
    w4 = nw4; a4 = na4; b4 = nb4; k4 = nk4; r4 = nr4; vv = nvv;
  }
  if (l16 == 0) {
#pragma unroll
    for (int st = 0; st < SCAN_TC; ++st) ob[st * 16 + rloc] = oacc[st];
  }
}

__device__ __forceinline__ void scan_item(const Params& p, int item, float* sm, HalfBar& hb) {
  const int tid = fresh_tid(), lane = tid & 63, wv = tid >> 6;
  float* obuf = sm + 2 * SCAN_TC * 384;
  const int l16 = lane & 15;
  const int rloc = wv * 4 + (lane >> 4);
  const int bh = item >> 2, rg = item & 3;
  const int b = bh >> 3, h = bh & 7;
  const int row = rg * 16 + rloc;
  const float4* src = (const float4*)(p.SC + (size_t)bh * SEQ * 384);
  float s0 = 0.f, s1 = 0.f, s2 = 0.f, s3 = 0.f;
  SCAN_PF_DECL(pfA); SCAN_PF_DECL(pfB);
  SCAN_PF_LOAD(pfA, 0)
  SCAN_PF_LOAD(pfB, 1)
  half_bar(hb);
  for (int c = 0; c < SCAN_NCH; c += 2) {
    SCAN_CHUNK(c, pfA)
    SCAN_CHUNK(c + 1, pfB)
  }
  half_bar(hb);
  {
    const int st = tid >> 4, r = tid & 15;
    p.ORAW[(size_t)(b * SEQ + (SCAN_NCH - 1) * SCAN_TC + st) * 512 + h * 64 + rg * 16 + r] = obuf[((SCAN_NCH - 1) & 1) * 256 + st * 16 + r];
  }
  half_bar(hb);
}

__device__ __forceinline__ void phase_rwkv_fin(const Params& p, int bid, int nb, float* sm) {
  const int tid = fresh_tid(), lane = tid & 63, wv = tid >> 6;
  for (int item = bid; item < T_TOK * 8 / 16; item += nb) {
    const int th0 = item * 16 + wv * 4;
    float o[4], bv[4], gg[4], lw[4], lb[4];
#pragma unroll
    for (int u = 0; u < 4; ++u) {
      const int th = th0 + u, t = th >> 3, c = (th & 7) * 64 + lane;
      o[u] = p.ORAW[(size_t)t * 512 + c];
      bv[u] = p.BV[(size_t)t * 512 + c];
      gg[u] = p.G[(size_t)t * 512 + c];
      lw[u] = p.ln_w[c];
      lb[u] = p.ln_b[c];
    }
#pragma unroll
    for (int u = 0; u < 4; ++u) {
      const int th = th0 + u, t = th >> 3, c = (th & 7) * 64 + lane;
      const float mu = wave_sum(o[u]) * (1.f / 64.f);
      const float d = o[u] - mu;
      const float var = wave_sum(d * d) * (1.f / 64.f);
      p.OCATb[(size_t)t * 1024 + c] = to_bf16((d * rsqrtf(var + 64e-5f) * lw[u] + lb[u] + bv[u]) * gg[u]);
    }
  }
  (void)sm;
}

__device__ __forceinline__ void phase_scores(const Params& p, int bid, int nb, float* smf, int nsl = 1) {
  bf16_t* sm = (bf16_t*)smf;
  float* iws = smf + 10240;
  MFMA_IDS
  for (int jw_ = 0;; ++jw_) {
    const int item = bid + (jw_ % nsl) + (jw_ / nsl) * nb;
    if (item >= 8 * 136) break;
    const int b = item / 136, pidx = item % 136;
    int tt = 0;
    while ((tt + 1) * (tt + 2) / 2 <= pidx) ++tt;
    const int st = pidx - tt * (tt + 1) / 2;
    __syncthreads();
    for (int i = tid; i < 1024; i += NTHR) iws[i] = p.IW[(size_t)(b * SEQ + tt * 128) * 8 + i];
    f32x16 sc[2][2];
#pragma unroll
    for (int i = 0; i < 2; ++i)
#pragma unroll
      for (int j = 0; j < 2; ++j)
#pragma unroll
        for (int q = 0; q < 16; ++q) sc[i][j][q] = 0.f;
    LoadRowsBF16 B;
    setup_rows(B, p.IKb, (size_t)(b * SEQ + st * 128) * 64, 64);
    LoadRowsBF16 A;
    setup_rows(A, p.IQb, (size_t)(b * SEQ + tt * 128) * 512, 512);
    f32x16 acc[2][2];
    auto step = [&](int it, f32x16 (&a)[2][2]) {
      if (it & 1) {
        const int h = it >> 1;
#pragma unroll
        for (int mi = 0; mi < 2; ++mi)
#pragma unroll
          for (int q = 0; q < 16; ++q) {
            const float w = iws[ACC_ROW(mi, q) * 8 + h];
            sc[mi][0][q] += w * fmaxf(a[mi][0][q] * 0.125f, 0.f);
            sc[mi][1][q] += w * fmaxf(a[mi][1][q] * 0.125f, 0.f);
            a[mi][0][q] = 0.f;
            a[mi][1][q] = 0.f;
          }
      }
    };
    mfma_gemm128(512, A, B, acc, sm, 0, 63, step);
#pragma unroll
    for (int mi = 0; mi < 2; ++mi)
#pragma unroll
      for (int ni = 0; ni < 2; ++ni)
#pragma unroll
        for (int q = 0; q < 16; ++q)
          p.SCORES[((size_t)(b * SEQ + tt * 128 + ACC_ROW(mi, q))) * SEQ + st * 128 + ACC_COL(ni)] = sc[mi][ni][q];
  }
}

__device__ __forceinline__ unsigned fkey(float f) {
  if (f == 0.f) f = 0.f;
  const unsigned u = __float_as_uint(f);
  return (u & 0x80000000u) ? ~u : (u | 0x80000000u);
}
template <int CTRL, int ROWMASK>
__device__ __forceinline__ int dpp_addi(int v) {
  return v + __builtin_amdgcn_update_dpp(0, v, CTRL, ROWMASK, 0xF, false);
}
__device__ __forceinline__ int wave_incl_scan(int v) {
  v = dpp_addi<0x111, 0xF>(v);
  v = dpp_addi<0x112, 0xF>(v);
  v = dpp_addi<0x114, 0xF>(v);
  v = dpp_addi<0x118, 0xF>(v);
  v = dpp_addi<0x142, 0xA>(v);
  v = dpp_addi<0x143, 0xC>(v);
  return v;
}
__device__ __forceinline__ void phase_topk(const Params& p, int bid, int nb, float* sm, int nsl = 1) {
  const int tid = fresh_tid(), lane = tid & 63, wv = tid >> 6;
  int* hist = (int*)sm + 10240 + wv * 256;
  float nraw[32];
  {
    const int q0 = bid * 4 + wv, t0 = q0 & (SEQ - 1);
    const float* r0 = p.SCORES + (size_t)(q0 < T_TOK ? q0 : 0) * SEQ;
#pragma unroll
    for (int i = 0; i < 32; ++i) { const int s = i * 64 + lane; nraw[i] = r0[s <= t0 ? s : t0]; }
  }
  for (int jw_ = 0;; ++jw_) {
    const int item = bid + (jw_ % nsl) + (jw_ / nsl) * nb;
    if (item >= T_TOK / 4) break;
    const int q = item * 4 + wv;
    const int t = q & (SEQ - 1);
    int* sel = p.SEL + (size_t)q * 256;
    unsigned key[32];
#pragma unroll
    for (int i = 0; i < 32; ++i) key[i] = ((i * 64 + lane) <= t) ? fkey(nraw[i]) : 0u;
    {
      const int itn = bid + ((jw_ + 1) % nsl) + ((jw_ + 1) / nsl) * nb;
      const int qn = (itn < T_TOK / 4) ? itn * 4 + wv : q;
      const int tn = qn & (SEQ - 1);
      const float* rn = p.SCORES + (size_t)qn * SEQ;
#pragma unroll
      for (int i = 0; i < 32; ++i) { const int s = i * 64 + lane; nraw[i] = rn[s <= tn ? s : tn]; }
    }
    if (t < 256) {
      for (int j = lane; j <= t; j += 64) sel[j] = j;
      continue;
    }
    unsigned prefix = 0;
    int rem = 256;
#pragma unroll
    for (int pass = 0; pass < 4; ++pass) {
      const int shift = 24 - 8 * pass;
      *(int4*)&hist[lane * 4] = make_int4(0, 0, 0, 0);
      asm volatile("s_waitcnt lgkmcnt(0)" ::: "memory");
#pragma unroll
      for (int i = 0; i < 32; ++i) {
        const bool valid = (i * 64 + lane) <= t;
        const bool match = valid && (pass == 0 || (key[i] >> (shift + 8)) == prefix);
        if (match) atomicAdd(&hist[(key[i] >> shift) & 255u], 1);
      }
      asm volatile("s_waitcnt lgkmcnt(0)" ::: "memory");
      const int4 hv = *(const int4*)&hist[252 - 4 * lane];
      const int tot = hv.x + hv.y + hv.z + hv.w;
      const int incl = wave_incl_scan(tot);
      const int excl = incl - tot;
      const bool mine = (excl < rem) && (rem <= incl);
      int d = 0, above = 0;
      {
        int a = excl;
        if (rem <= a + hv.w) { d = 255 - 4 * lane; above = a; }
        else {
          a += hv.w;
          if (rem <= a + hv.z) { d = 254 - 4 * lane; above = a; }
          else {
            a += hv.z;
            if (rem <= a + hv.y) { d = 253 - 4 * lane; above = a; }
            else { a += hv.y; d = 252 - 4 * lane; above = a; }
          }
        }
      }
      const unsigned long long mb = __ballot(mine);
      const int src = __ffsll((long long)mb) - 1;
      d = __builtin_amdgcn_readlane(d, src);
      above = __builtin_amdgcn_readlane(above, src);
      prefix = (prefix << 8) | (unsigned)d;
      rem -= above;
    }
    const unsigned T = prefix;
    const int need = rem;
    int pos = 0, tie_seen = 0;
#pragma unroll
    for (int i = 0; i < 32; ++i) {
      const bool valid = (i * 64 + lane) <= t;
      const bool gt = valid && key[i] > T;
      const bool eq = valid && key[i] == T;
      const unsigned long long meq = __ballot(eq);
      const int eq_before = __popcll(meq & ((1ull << lane) - 1ull));
      const bool take = gt || (eq && (tie_seen + eq_before) < need);
      const unsigned long long mt = __ballot(take);
      const int before = __popcll(mt & ((1ull << lane) - 1ull));
      if (take) sel[pos + before] = i * 64 + lane;
      pos += __popcll(mt);
      tie_seen += __popcll(meq);
    }
  }
}

typedef __attribute__((ext_vector_type(4))) float f32x4_t;
typedef __attribute__((ext_vector_type(4))) short s16x4_t;
#define AT_RS 288
__device__ __forceinline__ float swz_xor16(float v) {
  return __builtin_bit_cast(float, __builtin_amdgcn_ds_swizzle(__builtin_bit_cast(int, v), 0x401F));
}
__device__ __forceinline__ void phase_attn(const Params& p, int bid, int nb, float* smf, int nsl = 1) {
  const int tid = fresh_tid(), lane = tid & 63, wv = tid >> 6;
  const int n = lane & 15, g = lane >> 4, h8 = n & 7;
  char* img = (char*)smf + wv * (32 * AT_RS + 64);
  float* alph = (float*)(img + 32 * AT_RS);
  const unsigned img_base = (unsigned)(size_t)img;
  const float slope = exp2f(-(float)(h8 + 1));
  const int q_ = n >> 2, p_ = n & 3;
#define AT_GATHER(SELP, CLP, NSELV, CH)                                                 \
  {                                                                                     \
    const int jj_ = (CH) * 32 + g;                                                      \
    const int i0 = (SELP)[jj_ + 0 < (NSELV) ? jj_ + 0 : 0], i1 = (SELP)[jj_ + 4 < (NSELV) ? jj_ + 4 : 0];      \
    const int i2 = (SELP)[jj_ + 8 < (NSELV) ? jj_ + 8 : 0], i3 = (SELP)[jj_ + 12 < (NSELV) ? jj_ + 12 : 0];    \
    const int i4 = (SELP)[jj_ + 16 < (NSELV) ? jj_ + 16 : 0], i5 = (SELP)[jj_ + 20 < (NSELV) ? jj_ + 20 : 0];  \
    const int i6 = (SELP)[jj_ + 24 < (NSELV) ? jj_ + 24 : 0], i7 = (SELP)[jj_ + 28 < (NSELV) ? jj_ + 28 : 0];  \
    gv0 = *(const uint4*)((CLP) + (size_t)i0 * 128 + n * 8); gv1 = *(const uint4*)((CLP) + (size_t)i1 * 128 + n * 8); \
    gv2 = *(const uint4*)((CLP) + (size_t)i2 * 128 + n * 8); gv3 = *(const uint4*)((CLP) + (size_t)i3 * 128 + n * 8); \
    gv4 = *(const uint4*)((CLP) + (size_t)i4 * 128 + n * 8); gv5 = *(const uint4*)((CLP) + (size_t)i5 * 128 + n * 8); \
    gv6 = *(const uint4*)((CLP) + (size_t)i6 * 128 + n * 8); gv7 = *(const uint4*)((CLP) + (size_t)i7 * 128 + n * 8); \
  }
#define AT_QFRAGS(Q, F0, F1, F2, F3)                                         \
  {                                                                          \
    const bf16_t* qp_ = p.QABSb + (size_t)(Q) * 1024 + h8 * 128 + 8 * g;     \
    F0 = *(const bf16x8_t*)(qp_); F1 = *(const bf16x8_t*)(qp_ + 32);         \
    F2 = *(const bf16x8_t*)(qp_ + 64); F3 = *(const bf16x8_t*)(qp_ + 96);    \
  }
#define AT_NSEL(Q) __builtin_amdgcn_readfirstlane((((Q) & (SEQ - 1)) < 256) ? ((Q) & (SEQ - 1)) + 1 : 256)
  uint4 gv0, gv1, gv2, gv3, gv4, gv5, gv6, gv7;
  bf16x8_t qf0, qf1, qf2, qf3;
  int nsel;
  {
    const int q0 = (bid < T_TOK / 4) ? bid * 4 + wv : 0;
    nsel = AT_NSEL(q0);
    AT_QFRAGS(q0, qf0, qf1, qf2, qf3)
    AT_GATHER(p.SEL + (size_t)q0 * 256, p.CLATb + (size_t)(q0 >> 11) * SEQ * 128, nsel, 0)
  }
  for (int jw_ = 0;; ++jw_) {
    const int item = bid + (jw_ % nsl) + (jw_ / nsl) * nb;
    if (item >= T_TOK / 4) break;
    const int q = item * 4 + wv;
    const int t = q & (SEQ - 1), b = q >> 11;
    const int nch = (nsel + 31) >> 5;
    const int* sel = p.SEL + (size_t)q * 256;
    const bf16_t* cl = p.CLATb + (size_t)b * SEQ * 128;
    const int itn = bid + ((jw_ + 1) % nsl) + ((jw_ + 1) / nsl) * nb;
    const int qn = (itn < T_TOK / 4) ? itn * 4 + wv : q;
    const int nsel_n_v = AT_NSEL(qn);
    bf16x8_t qn0, qn1, qn2, qn3;
    AT_QFRAGS(qn, qn0, qn1, qn2, qn3)
    float m_run = -1e30f, l_run = 0.f;
    f32x4_t O0 = {0.f, 0.f, 0.f, 0.f}, O1 = O0, O2 = O0, O3 = O0, O4 = O0, O5 = O0, O6 = O0, O7 = O0;
    for (int c = 0; c < nch; ++c) {
      {
        char* wr_ = img + g * AT_RS + n * 16;
        *(uint4*)(wr_ + 0 * 4 * AT_RS) = gv0; *(uint4*)(wr_ + 1 * 4 * AT_RS) = gv1; *(uint4*)(wr_ + 2 * 4 * AT_RS) = gv2;
        *(uint4*)(wr_ + 3 * 4 * AT_RS) = gv3; *(uint4*)(wr_ + 4 * 4 * AT_RS) = gv4; *(uint4*)(wr_ + 5 * 4 * AT_RS) = gv5;
        *(uint4*)(wr_ + 6 * 4 * AT_RS) = gv6; *(uint4*)(wr_ + 7 * 4 * AT_RS) = gv7;
      }
      if (c + 1 < nch) {
        AT_GATHER(sel, cl, nsel, c + 1)
      } else {
        const int nsn = __builtin_amdgcn_readfirstlane(nsel_n_v);
        AT_GATHER(p.SEL + (size_t)qn * 256, p.CLATb + (size_t)(qn >> 11) * SEQ * 128, nsn, 0)
      }
      const int jb = c * 32 + 4 * g;
      const int4 pa = *(const int4*)&sel[jb];
      const int4 pb = *(const int4*)&sel[jb + 16];
      asm volatile("s_waitcnt lgkmcnt(0)" ::: "memory");
      f32x4_t S0 = {0.f, 0.f, 0.f, 0.f}, S1 = S0;
      {
        const char* ar = img + n * AT_RS + g * 16;
        const bf16x8_t a00 = *(const bf16x8_t*)(ar), a01 = *(const bf16x8_t*)(ar + 64), a02 = *(const bf16x8_t*)(ar + 128),
                       a03 = *(const bf16x8_t*)(ar + 192);
        const char* ar1 = ar + 16 * AT_RS;
        const bf16x8_t a10 = *(const bf16x8_t*)(ar1), a11 = *(const bf16x8_t*)(ar1 + 64), a12 = *(const bf16x8_t*)(ar1 + 128),
                       a13 = *(const bf16x8_t*)(ar1 + 192);
        S0 = __builtin_amdgcn_mfma_f32_16x16x32_bf16(a00, qf0, S0, 0, 0, 0);
        S1 = __builtin_amdgcn_mfma_f32_16x16x32_bf16(a10, qf0, S1, 0, 0, 0);
        S0 = __builtin_amdgcn_mfma_f32_16x16x32_bf16(a01, qf1, S0, 0, 0, 0);
        S1 = __builtin_amdgcn_mfma_f32_16x16x32_bf16(a11, qf1, S1, 0, 0, 0);
        S0 = __builtin_amdgcn_mfma_f32_16x16x32_bf16(a02, qf2, S0, 0, 0, 0);
        S1 = __builtin_amdgcn_mfma_f32_16x16x32_bf16(a12, qf2, S1, 0, 0, 0);
        S0 = __builtin_amdgcn_mfma_f32_16x16x32_bf16(a03, qf3, S0, 0, 0, 0);
        S1 = __builtin_amdgcn_mfma_f32_16x16x32_bf16(a13, qf3, S1, 0, 0, 0);
      }
      float s0 = S0[0] * 0.125f - slope * (float)(t - pa.x), s1 = S0[1] * 0.125f - slope * (float)(t - pa.y);
      float s2 = S0[2] * 0.125f - slope * (float)(t - pa.z), s3 = S0[3] * 0.125f - slope * (float)(t - pa.w);
      float s4 = S1[0] * 0.125f - slope * (float)(t - pb.x), s5 = S1[1] * 0.125f - slope * (float)(t - pb.y);
      float s6 = S1[2] * 0.125f - slope * (float)(t - pb.z), s7 = S1[3] * 0.125f - slope * (float)(t - pb.w);
      s0 = (jb + 0 < nsel) ? s0 : -1e30f; s1 = (jb + 1 < nsel) ? s1 : -1e30f;
      s2 = (jb + 2 < nsel) ? s2 : -1e30f; s3 = (jb + 3 < nsel) ? s3 : -1e30f;
      s4 = (jb + 16 < nsel) ? s4 : -1e30f; s5 = (jb + 17 < nsel) ? s5 : -1e30f;
      s6 = (jb + 18 < nsel) ? s6 : -1e30f; s7 = (jb + 19 < nsel) ? s7 : -1e30f;
      float cm = fmaxf(fmaxf(fmaxf(s0, s1), fmaxf(s2, s3)), fmaxf(fmaxf(s4, s5), fmaxf(s6, s7)));
      cm = fmaxf(cm, swz_xor16(cm));
      cm = fmaxf(cm, __shfl_xor(cm, 32, 64));
      const float m_new = fmaxf(m_run, cm);
      const float alpha = fexp(m_run - m_new);
      m_run = m_new;
      s0 = fexp(s0 - m_new); s1 = fexp(s1 - m_new); s2 = fexp(s2 - m_new); s3 = fexp(s3 - m_new);
      s4 = fexp(s4 - m_new); s5 = fexp(s5 - m_new); s6 = fexp(s6 - m_new); s7 = fexp(s7 - m_new);
      l_run = l_run * alpha + ((s0 + s1) + (s2 + s3)) + ((s4 + s5) + (s6 + s7));
      uint4 pk;
      pk.x = pack_bf16(s0, s1); pk.y = pack_bf16(s2, s3); pk.z = pack_bf16(s4, s5); pk.w = pack_bf16(s6, s7);
      const bf16x8_t pf = __builtin_bit_cast(bf16x8_t, pk);
      if (g == 0) alph[n] = alpha;
      asm volatile("s_waitcnt lgkmcnt(0)" ::: "memory");
      const float4 al = *(const float4*)&alph[4 * (g & 1)];
      asm volatile("s_waitcnt lgkmcnt(0)" ::: "memory");
      const f32x4_t av = {al.x, al.y, al.z, al.w};
      O0 *= av; O1 *= av; O2 *= av; O3 *= av; O4 *= av; O5 *= av; O6 *= av; O7 *= av;
      const unsigned ta = img_base + (4 * g + q_) * AT_RS + 8 * p_;
      {
        s16x4_t l0, l1, l2, l3, l4, l5, l6, l7, h0, h1, h2, h3, h4, h5, h6, h7;
        asm volatile(
            "ds_read_b64_tr_b16 %0, %16\n\t"
            "ds_read_b64_tr_b16 %1, %16 offset:32\n\t"
            "ds_read_b64_tr_b16 %2, %16 offset:64\n\t"
            "ds_read_b64_tr_b16 %3, %16 offset:96\n\t"
            "ds_read_b64_tr_b16 %4, %16 offset:128\n\t"
            "ds_read_b64_tr_b16 %5, %16 offset:160\n\t"
            "ds_read_b64_tr_b16 %6, %16 offset:192\n\t"
            "ds_read_b64_tr_b16 %7, %16 offset:224\n\t"
            "ds_read_b64_tr_b16 %8, %16 offset:4608\n\t"
            "ds_read_b64_tr_b16 %9, %16 offset:4640\n\t"
            "ds_read_b64_tr_b16 %10, %16 offset:4672\n\t"
            "ds_read_b64_tr_b16 %11, %16 offset:4704\n\t"
            "ds_read_b64_tr_b16 %12, %16 offset:4736\n\t"
            "ds_read_b64_tr_b16 %13, %16 offset:4768\n\t"
            "ds_read_b64_tr_b16 %14, %16 offset:4800\n\t"
            "ds_read_b64_tr_b16 %15, %16 offset:4832\n\t"
            "s_waitcnt lgkmcnt(0)"
            : "=&v"(l0), "=&v"(l1), "=&v"(l2), "=&v"(l3), "=&v"(l4), "=&v"(l5), "=&v"(l6), "=&v"(l7), "=&v"(h0), "=&v"(h1),
              "=&v"(h2), "=&v"(h3), "=&v"(h4), "=&v"(h5), "=&v"(h6), "=&v"(h7)
            : "v"(ta)
            : "memory");
#define AT_PV(OX, LO, HI) OX = __builtin_amdgcn_mfma_f32_16x16x32_bf16(pf, __builtin_shufflevector(LO, HI, 0, 1, 2, 3, 4, 5, 6, 7), OX, 0, 0, 0);
        AT_PV(O0, l0, h0) AT_PV(O1, l1, h1) AT_PV(O2, l2, h2) AT_PV(O3, l3, h3)
        AT_PV(O4, l4, h4) AT_PV(O5, l5, h5) AT_PV(O6, l6, h6) AT_PV(O7, l7, h7)
#undef AT_PV
      }
    }
    float lt = l_run + swz_xor16(l_run);
    lt += __shfl_xor(lt, 32, 64);
    if (g == 0) alph[n] = frcp(lt);
    asm volatile("s_waitcnt lgkmcnt(0)" ::: "memory");
    const float4 il = *(const float4*)&alph[4 * (g & 1)];
    asm volatile("s_waitcnt lgkmcnt(0)" ::: "memory");
    if (g < 2) {
      bf16_t* o = p.OLATb + (size_t)q * 1024 + (4 * g) * 128 + n;
#define AT_ST(OX, CT)                                   \
  o[0 * 128 + (CT) * 16] = to_bf16(OX[0] * il.x);       \
  o[1 * 128 + (CT) * 16] = to_bf16(OX[1] * il.y);       \
  o[2 * 128 + (CT) * 16] = to_bf16(OX[2] * il.z);       \
  o[3 * 128 + (CT) * 16] = to_bf16(OX[3] * il.w);
      AT_ST(O0, 0) AT_ST(O1, 1) AT_ST(O2, 2) AT_ST(O3, 3) AT_ST(O4, 4) AT_ST(O5, 5) AT_ST(O6, 6) AT_ST(O7, 7)
    }
    nsel = __builtin_amdgcn_readfirstlane(nsel_n_v);
    qf0 = qn0; qf1 = qn1; qf2 = qn2; qf3 = qn3;
  }
}

__device__ __forceinline__ void phase_uv(const Params& p, int bid, int nb, float* smf) {
  bf16_t* sm = (bf16_t*)smf;
  MFMA_IDS
  for (int item = bid; item < 128 * 8; item += nb) {
    const int h = item & 7, mt = item >> 3;
    LoadRowsBF16 A;
    setup_rows(A, p.OLATb, (size_t)mt * 128 * 1024 + h * 128, 1024);
    LoadWeightKN B;
    setup_weight(B, p.w_uv, (size_t)h * 128 * 64, 64, 63);
    f32x16 acc[2][2];
    mfma_gemm128(128, A, B, acc, sm);
    if (wc == 0) {
#pragma unroll
      for (int mi = 0; mi < 2; ++mi)
#pragma unroll
        for (int ni = 0; ni < 2; ++ni)
#pragma unroll
          for (int q = 0; q < 16; ++q)
            p.OCATb[(size_t)(mt * 128 + ACC_ROW(mi, q)) * 1024 + 512 + h * 64 + ni * 32 + r] = to_bf16(acc[mi][ni][q]);
    }
  }
}

#define ALPHA_RES 1.189207115002721f
__device__ __forceinline__ void phase_outproj(const Params& p, int bid, int nb, float* smf) {
  bf16_t* sm = (bf16_t*)smf;
  MFMA_IDS
  for (int item = bid; item < 64 * 8; item += nb) {
    const int nt = item & 7, mt = item >> 3;
    const int bb = (mt * 256) >> 11;
    LoadRows4 A;
    setup_rows4(A, p.OCATb, (size_t)mt * 256 * 1024, 1024);
    LoadWeightKN B;
    setup_weight(B, p.w_out, (size_t)nt * 128, 1024, 127);
    f32x16 acc[4][2];
    mfma_gemm256(1024, A, B, acc, sm, 0);
    epilogue256_staged(acc, smf, [&](int row, int col, const float4& v) {
      const size_t off = (size_t)(mt * 256 + row) * 1024 + nt * 128 + col;
      const float4 xv = *(const float4*)&p.x[off];
      const float4 gt = *(const float4*)&p.mod[bb * 6144 + 2048 + nt * 128 + col];
      *(float4*)&p.Y1[off] = make_float4(ALPHA_RES * xv.x + (1.f + gt.x) * v.x, ALPHA_RES * xv.y + (1.f + gt.y) * v.y,
                                         ALPHA_RES * xv.z + (1.f + gt.z) * v.z, ALPHA_RES * xv.w + (1.f + gt.w) * v.w);
    });
  }
}


__device__ __forceinline__ void phase_ln1_router(const Params& p, int bid, int nb, float* sm) {
  const int tid = fresh_tid(), lane = tid & 63, wv = tid >> 6;
  float* us = sm;
  float* part = sm + 8192;
  float* lg = sm + 8192 + 2048;
  for (int item = bid; item < T_TOK / 8; item += nb) {
    const int t0 = item * 8;
    const int b = t0 >> 11;
    __syncthreads();
    for (int tk = wv * 2; tk < wv * 2 + 2; ++tk) {
      const int t = t0 + tk;
      float4 y[4];
#pragma unroll
      for (int i = 0; i < 4; ++i) y[i] = *(const float4*)&p.Y1[(size_t)t * 1024 + i * 256 + lane * 4];
      float sacc = 0.f;
#pragma unroll
      for (int i = 0; i < 4; ++i) sacc += y[i].x + y[i].y + y[i].z + y[i].w;
      const float mu = wave_sum(sacc) * (1.f / 1024.f);
      float vacc = 0.f;
#pragma unroll
      for (int i = 0; i < 4; ++i) {
        y[i].x -= mu; y[i].y -= mu; y[i].z -= mu; y[i].w -= mu;
        vacc += y[i].x * y[i].x + y[i].y * y[i].y + y[i].z * y[i].z + y[i].w * y[i].w;
      }
      const float rs = rsqrtf(wave_sum(vacc) * (1.f / 1024.f) + 1e-5f);
      if (lane == 0) *(float2*)&p.X1[(size_t)t * 2] = make_float2(mu, rs);
#pragma unroll
      for (int i = 0; i < 4; ++i) {
        const int k = i * 256 + lane * 4;
        const float4 g = *(const float4*)&p.ln1_g[k];
        const float4 be = *(const float4*)&p.ln1_b[k];
        const float4 x1 = make_float4(y[i].x * rs * g.x + be.x, y[i].y * rs * g.y + be.y, y[i].z * rs * g.z + be.z, y[i].w * rs * g.w + be.w);
        const float4 sh = *(const float4*)&p.mod[b * 6144 + 3072 + k];
        const float4 sc = *(const float4*)&p.mod[b * 6144 + 4096 + k];
        const float4 u2 = make_float4(x1.x * (1.f + sc.x) + sh.x, x1.y * (1.f + sc.y) + sh.y, x1.z * (1.f + sc.z) + sh.z, x1.w * (1.f + sc.w) + sh.w);
        *(uint2*)&p.U2[(size_t)t * 1024 + k] = make_uint2(pack_bf16(u2.x, u2.y), pack_bf16(u2.z, u2.w));
        us[(k + 0) * 8 + tk] = u2.x;
        us[(k + 1) * 8 + tk] = u2.y;
        us[(k + 2) * 8 + tk] = u2.z;
        us[(k + 3) * 8 + tk] = u2.w;
      }
    }
    __syncthreads();
    {
      const int e = lane & 31, kh = lane >> 5;
      const int kbeg = wv * 256 + kh * 128;
      float a0 = 0.f, a1 = 0.f, a2 = 0.f, a3 = 0.f, a4 = 0.f, a5 = 0.f, a6 = 0.f, a7 = 0.f;
      {
        const float* wp = p.w_router + kbeg * 32 + e;
        float wn0 = wp[0], wn1 = wp[32], wn2 = wp[64], wn3 = wp[96], wn4 = wp[128], wn5 = wp[160], wn6 = wp[192], wn7 = wp[224];
        for (int k0 = 0; k0 < 128; k0 += 8) {
          const float wc0 = wn0, wc1 = wn1, wc2 = wn2, wc3 = wn3, wc4 = wn4, wc5 = wn5, wc6 = wn6, wc7 = wn7;
          const float* wq = wp + ((k0 + 8 < 128) ? k0 + 8 : k0) * 32;
          wn0 = wq[0]; wn1 = wq[32]; wn2 = wq[64]; wn3 = wq[96]; wn4 = wq[128]; wn5 = wq[160]; wn6 = wq[192]; wn7 = wq[224];
          const float* ub = us + (kbeg + k0) * 8;
#define RT_STEP(KK, W)                                                                                   \
  {                                                                                                      \
    const float4 ua = *(const float4*)&ub[(KK) * 8], ubb = *(const float4*)&ub[(KK) * 8 + 4];            \
    a0 = fmaf(ua.x, W, a0); a1 = fmaf(ua.y, W, a1); a2 = fmaf(ua.z, W, a2); a3 = fmaf(ua.w, W, a3);      \
    a4 = fmaf(ubb.x, W, a4); a5 = fmaf(ubb.y, W, a5); a6 = fmaf(ubb.z, W, a6); a7 = fmaf(ubb.w, W, a7);  \
  }
          RT_STEP(0, wc0) RT_STEP(1, wc1) RT_STEP(2, wc2) RT_STEP(3, wc3) RT_STEP(4, wc4) RT_STEP(5, wc5) RT_STEP(6, wc6) RT_STEP(7, wc7)
#undef RT_STEP
        }
      }
      float* pp = part + ((wv * 2 + kh) * 8) * 32 + e;
      pp[0 * 32] = a0; pp[1 * 32] = a1; pp[2 * 32] = a2; pp[3 * 32] = a3;
      pp[4 * 32] = a4; pp[5 * 32] = a5; pp[6 * 32] = a6; pp[7 * 32] = a7;
    }
    __syncthreads();
    {
      const int tk = tid >> 5, e = tid & 31;
      float v = p.b_router[e];
#pragma unroll
      for (int i = 0; i < 8; ++i) v += part[(i * 8 + tk) * 32 + e];
      bool used = false;
      float val0 = 0.f, val1 = 0.f, val2 = 0.f, val3 = 0.f;
      int id0 = 0, id1 = 0, id2 = 0, id3 = 0;
#pragma unroll
      for (int k = 0; k < 4; ++k) {
        const float cand = used ? -3.4e38f : v;
        float m = cand;
        m = fmaxf(m, __shfl_xor(m, 1, 64));
        m = fmaxf(m, __shfl_xor(m, 2, 64));
        m = fmaxf(m, __shfl_xor(m, 4, 64));
        m = fmaxf(m, __shfl_xor(m, 8, 64));
        m = fmaxf(m, __shfl_xor(m, 16, 64));
        const unsigned long long bal = __ballot(!used && cand == m);
        const unsigned half = (unsigned)(bal >> (32 * (lane >> 5)));
        const int win = __ffs((int)half) - 1;
        if (k == 0) { val0 = m; id0 = win; }
        if (k == 1) { val1 = m; id1 = win; }
        if (k == 2) { val2 = m; id2 = win; }
        if (k == 3) { val3 = m; id3 = win; }
        if (e == win) used = true;
      }
      if (e < 4) {
        const int t = t0 + tk;
        const float e0 = 1.f, e1 = expf(val1 - val0), e2 = expf(val2 - val0), e3 = expf(val3 - val0);
        const float ssum = (e0 + e1) + (e2 + e3);
        const float mine = (e == 0) ? e0 : (e == 1) ? e1 : (e == 2) ? e2 : e3;
        const int ex = (e == 0) ? id0 : (e == 1) ? id1 : (e == 2) ? id2 : id3;
        p.pgate[t * 4 + e] = mine / ssum;
        const int pos = atomicAdd(&p.cnt[ex * CNT_STRIDE], 1);
        p.lists[ex * T_TOK + pos] = t * 4 + e;
        p.lgate[ex * T_TOK + pos] = mine / ssum;
      }
    }
  }
}

__device__ __forceinline__ void moe_meta_build(const Params& p, int* meta) {
  __syncthreads();
  if (fresh_tid() < 32) meta[fresh_tid()] = p.cnt[fresh_tid() * CNT_STRIDE];
  __syncthreads();
  if (fresh_tid() == 0) {
    int tp = 0, rp = 0;
    for (int e = 0; e < 32; ++e) {
      meta[32 + e] = tp;
      meta[64 + e] = rp;
      tp += (meta[e] + 255) >> 8;
      rp += meta[e];
    }
    meta[96] = tp;
  }
  __syncthreads();
}
__device__ __forceinline__ bool moe_item(const int* meta, int item, int ntn, int& e, int& mt, int& nt) {
  if (item >= meta[96] * ntn) return false;
  int ee = 0;
  while (ee < 31 && item >= meta[32 + ee + 1] * ntn) ++ee;
  const int tiles = (meta[ee] + 255) >> 8;
  const int loc = item - meta[32 + ee] * ntn;
  e = ee;
  nt = loc / tiles;
  mt = loc - nt * tiles;
  return true;
}
#define HS_STR 72

__device__ __forceinline__ void phase_moe(const Params& p, int vbid, int nb, float* smf) {
  bf16_t* sm = (bf16_t*)smf;
  int* meta = (int*)(smf + 15360);
  int* prs = (int*)(smf + 15360 + 128);
  float* gts = smf + 15360 + 384;
  const int tid = fresh_tid(), lane = tid & 63, wv = tid >> 6;
  const int wr = wv >> 1, wc = wv & 1, r = lane & 31, hh = lane >> 5;
  moe_meta_build(p, meta);
  const int N1 = meta[96] * 16, N2 = meta[96] * 8;
  for (int item = vbid; item < N1 + N2; item += nb) {
    int e, mt, nt;
    if (item < N1) {
      moe_item(meta, item, 16, e, mt, nt);
      e = __builtin_amdgcn_readfirstlane(e); mt = __builtin_amdgcn_readfirstlane(mt); nt = __builtin_amdgcn_readfirstlane(nt);
    const int cnt = meta[e], ebase = meta[64 + e];
    const int* lst = p.lists + e * T_TOK;
    const __amdgpu_buffer_rsrc_t hrs = make_rsrc(p.Hb);
    LoadRows4 A;
    {
      const int row0 = tid >> 2, kc = tid & 3;
      const int g0 = mt * 256 + row0;
      A.rs = make_rsrc(p.U2);
      A.off0 = (lst[g0 < cnt ? g0 : 0] >> 2) * 2048 + kc * 16;
      A.off1 = (lst[g0 + 64 < cnt ? g0 + 64 : 0] >> 2) * 2048 + kc * 16;
      A.off2 = (lst[g0 + 128 < cnt ? g0 + 128 : 0] >> 2) * 2048 + kc * 16;
      A.off3 = (lst[g0 + 192 < cnt ? g0 + 192 : 0] >> 2) * 2048 + kc * 16;
      A.o = row0 * LSTR + kc * 8;
    }
    LoadWeightKN B;
    {
      const int cl = tid & 127, kh = __builtin_amdgcn_readfirstlane(tid >> 7);
      const int hl = cl >> 1, sub = cl & 1;
      const int nl = (hl >> 5) * 64 + sub * 32 + (hl & 31);
      B.rs = make_rsrc(p.w_gu);
      B.ldb4 = 2048 * 4;
      B.soff = (int)((((size_t)e * 1024 + kh * 16) * 2048 + nt * 128) * 4);
      B.voff = cl * 4;
      B.o = nl * LSTR + kh * 16;
    }
    f32x16 acc[4][2];
    mfma_gemm256(1024, A, B, acc, sm, 0);
    const int hcol = nt * 64 + wc * 32 + r;
    const float bgate = p.b_gu[e * 2048 + 2 * hcol], bup = p.b_gu[e * 2048 + 2 * hcol + 1];
#pragma unroll
    for (int mi = 0; mi < 4; ++mi)
#pragma unroll
      for (int q = 0; q < 16; ++q) {
        const int row = wr * 128 + mi * 32 + (q & 3) + 8 * (q >> 2) + 4 * hh;
        const float g = fminf(acc[mi][0][q] + bgate, 7.f);
        const float u = fminf(fmaxf(acc[mi][1][q] + bup, -7.f), 7.f);
        const float hv = (u + 1.f) * (g * sigmoidf_(g * 1.702f));
        sm[row * HS_STR + wc * 32 + r] = to_bf16(hv);
      }
    __syncthreads();
#pragma unroll
    for (int i = 0; i < 8; ++i) {
      const int c = tid + i * NTHR, row = c >> 3, ch = c & 7;
      const int grow = mt * 256 + row;
      if (grow < cnt)
        __builtin_amdgcn_raw_buffer_store_b128(*(const u32x4_t*)&sm[row * HS_STR + ch * 8], hrs, ((ebase + grow) * 1024 + nt * 64 + ch * 8) * 2, 0, 16);
    }
    asm volatile("s_waitcnt vmcnt(0)" ::: "memory");
    __syncthreads();
    if (tid == 0) __hip_atomic_fetch_add(&p.moe_done[e * 64 + mt], 1, __ATOMIC_RELAXED, __HIP_MEMORY_SCOPE_AGENT);
    } else {
      moe_item(meta, item - N1, 8, e, mt, nt);
      e = __builtin_amdgcn_readfirstlane(e); mt = __builtin_amdgcn_readfirstlane(mt); nt = __builtin_amdgcn_readfirstlane(nt);
    const int cnt = meta[e], ebase = meta[64 + e];
    const int* lst = p.lists + e * T_TOK;
    if (tid == 0) {
      unsigned sp = 0;
      while (__hip_atomic_load(&p.moe_done[e * 64 + mt], __ATOMIC_RELAXED, __HIP_MEMORY_SCOPE_AGENT) < 16) {
        __builtin_amdgcn_s_sleep(4);
        if (++sp > (1u << 24)) break;
      }
      __builtin_amdgcn_fence(__ATOMIC_ACQUIRE, "agent");
      asm volatile("s_waitcnt vmcnt(0)" ::: "memory");
    }
    {
      const int grow = mt * 256 + tid;
      const int pr = (grow < cnt) ? lst[grow] : -1;
      prs[tid] = pr;
      gts[tid] = (pr >= 0) ? p.pgate[pr] : 0.f;
    }
    __syncthreads();
    LoadRows4 A;
    {
      const int row0 = tid >> 2, kc = tid & 3;
      const int g0 = mt * 256 + row0;
      A.rs = make_rsrc(p.Hb);
      A.off0 = (ebase + (g0 < cnt ? g0 : 0)) * 2048 + kc * 16;
      A.off1 = (ebase + (g0 + 64 < cnt ? g0 + 64 : 0)) * 2048 + kc * 16;
      A.off2 = (ebase + (g0 + 128 < cnt ? g0 + 128 : 0)) * 2048 + kc * 16;
      A.off3 = (ebase + (g0 + 192 < cnt ? g0 + 192 : 0)) * 2048 + kc * 16;
      A.o = row0 * LSTR + kc * 8;
    }
    LoadWeightKN B;
    {
      const int cl = tid & 127, kh = __builtin_amdgcn_readfirstlane(tid >> 7);
      B.rs = make_rsrc(p.w_dn);
      B.ldb4 = 1024 * 4;
      B.soff = (int)((((size_t)e * 1024 + kh * 16) * 1024 + nt * 128) * 4);
      B.voff = cl * 4;
      B.o = cl * LSTR + kh * 16;
    }
    f32x16 acc[4][2];
    mfma_gemm256(1024, A, B, acc, sm, 0);
    for (int pass = 0; pass < 2; ++pass) {
      if (wc == pass) {
#pragma unroll
        for (int mi = 0; mi < 4; ++mi)
#pragma unroll
          for (int q = 0; q < 16; ++q) {
            const int row = wr * 128 + mi * 32 + (q & 3) + 8 * (q >> 2) + 4 * hh;
            sm[row * HS_STR + r] = to_bf16(acc[mi][0][q]);
            sm[row * HS_STR + 32 + r] = to_bf16(acc[mi][1][q]);
          }
      }
      __syncthreads();
#pragma unroll
      for (int i = 0; i < 8; ++i) {
        const int c = tid + i * NTHR, row = c >> 3, ch = c & 7;
        const int grow = mt * 256 + row;
        if (grow < cnt) {
          const int pair = prs[row];
          const float gt = gts[row];
          const int col = nt * 128 + pass * 64 + ch * 8;
          const uint4 v = *(const uint4*)&sm[row * HS_STR + ch * 8];
          const float4 b0 = *(const float4*)&p.b_dn[e * 1024 + col], b1 = *(const float4*)&p.b_dn[e * 1024 + col + 4];
          uint4 o;
          o.x = pack_bf16((bf16_lo(v.x) + b0.x) * gt, (bf16_hi(v.x) + b0.y) * gt);
          o.y = pack_bf16((bf16_lo(v.y) + b0.z) * gt, (bf16_hi(v.y) + b0.w) * gt);
          o.z = pack_bf16((bf16_lo(v.z) + b1.x) * gt, (bf16_hi(v.z) + b1.y) * gt);
          o.w = pack_bf16((bf16_lo(v.w) + b1.z) * gt, (bf16_hi(v.w) + b1.w) * gt);
          *(uint4*)&p.POb[(size_t)pair * 1024 + col] = o;
        }
      }
      __syncthreads();
    }
    }
  }
}

__device__ __forceinline__ void phase_final(const Params& p, int bid, int nb, float* sm) {
  const int tid = fresh_tid(), lane = tid & 63, wv = tid >> 6;
  for (int item = bid; item < T_TOK / 4; item += nb) {
    const int t = item * 4 + wv;
    const int b = t >> 11;
    const float2 st1 = *(const float2*)&p.X1[(size_t)t * 2];
    float y[16];
#pragma unroll
    for (int i = 0; i < 4; ++i) {
      const int k = i * 256 + lane * 4;
      float4 f = make_float4(0.f, 0.f, 0.f, 0.f);
#pragma unroll
      for (int e = 0; e < 4; ++e) {
        const uint2 v = *(const uint2*)&p.POb[((size_t)t * 4 + e) * 1024 + k];
        f.x += bf16_lo(v.x); f.y += bf16_hi(v.x); f.z += bf16_lo(v.y); f.w += bf16_hi(v.y);
      }
      const float4 yv = *(const float4*)&p.Y1[(size_t)t * 1024 + k];
      const float4 g1 = *(const float4*)&p.ln1_g[k];
      const float4 b1 = *(const float4*)&p.ln1_b[k];
      const float4 x1 = make_float4((yv.x - st1.x) * st1.y * g1.x + b1.x, (yv.y - st1.x) * st1.y * g1.y + b1.y,
                                    (yv.z - st1.x) * st1.y * g1.z + b1.z, (yv.w - st1.x) * st1.y * g1.w + b1.w);
      const float4 gt = *(const float4*)&p.mod[b * 6144 + 5120 + k];
      y[i * 4 + 0] = ALPHA_RES * x1.x + (1.f + gt.x) * f.x;
      y[i * 4 + 1] = ALPHA_RES * x1.y + (1.f + gt.y) * f.y;
      y[i * 4 + 2] = ALPHA_RES * x1.z + (1.f + gt.z) * f.z;
      y[i * 4 + 3] = ALPHA_RES * x1.w + (1.f + gt.w) * f.w;
    }
    float sacc = 0.f;
#pragma unroll
    for (int i = 0; i < 16; ++i) sacc += y[i];
    const float mu = wave_sum(sacc) * (1.f / 1024.f);
    float vacc = 0.f;
#pragma unroll
    for (int i = 0; i < 16; ++i) { y[i] -= mu; vacc += y[i] * y[i]; }
    const float rs = rsqrtf(wave_sum(vacc) * (1.f / 1024.f) + 1e-5f);
#pragma unroll
    for (int i = 0; i < 4; ++i) {
      const int k = i * 256 + lane * 4;
      const float4 g = *(const float4*)&p.ln2_g[k];
      const float4 be = *(const float4*)&p.ln2_b[k];
      *(float4*)&p.out[(size_t)t * 1024 + k] = make_float4(y[i * 4 + 0] * rs * g.x + be.x, y[i * 4 + 1] * rs * g.y + be.y,
                                                            y[i * 4 + 2] * rs * g.z + be.z, y[i * 4 + 3] * rs * g.w + be.w);
    }
  }
  (void)sm;
}

#define HALF_FLOATS 16384
#define MISC_OFF (2 * HALF_FLOATS * 4)
#define TAB_OFF (MISC_OFF + 4096)
#define LDS_BYTES (TAB_OFF + 8192)
namespace pg {
typedef short bf16x8 __attribute__((ext_vector_type(8)));
typedef float f32x4 __attribute__((ext_vector_type(4)));
constexpr int BK = 64, HALF = 128, HTB = HALF * BK * 2, KD = 1024;
__device__ __forceinline__ int lds_byte(int r, int c) { const int st = (r >> 4) * 2 + (c >> 5), rr = r & 15, cc = c & 31, ob = rr * 64 + cc * 2; return st * 1024 + (ob ^ (((ob >> 9) & 1) << 5)); }
__device__ __forceinline__ void stage_rc(int b, int& R, int& C) { const int st = b / 1024, sb = b % 1024, swz = sb ^ (((sb >> 9) & 1) << 5); R = (st >> 1) * 16 + swz / 64; C = (st & 1) * 32 + (swz % 64) / 2; }
__device__ __forceinline__ int perm32(int rho) { const int n = rho >> 4, i = rho & 15; return 8 * (i >> 2) + 4 * n + (i & 3); }

template <class S_t>
__device__ __forceinline__ void stream(LAS unsigned char* lds, const S_t& S) {
  const int tid = fresh_tid512(), wid = __builtin_amdgcn_readfirstlane(tid >> 6), lane = tid & 63, wr = wid >> 2, wc = wid & 3, fr = lane & 15, fq = lane >> 4;
  constexpr int K = KD, nt = K / BK;
  unsigned voffB[2], c2 = 0;
#pragma unroll
  for (int i = 0; i < 2; ++i) { int R, C; stage_rc(tid * 16 + i * 8192, R, C); const int Rb = (R & ~31) + perm32(R & 31); voffB[i] = (unsigned)(Rb * K + C) * 2u; c2 = (unsigned)C * 2u; }
  constexpr size_t kstep = (size_t)(BK * 2);
  constexpr size_t hstep = (size_t)HALF * K * 2;
  const unsigned ldsw = (unsigned)wid * 1024u;
  LAS int* tabw = (LAS int*)(lds + TAB_OFF) + wid * 256;
  const int aoff = lds_byte(wr * 64 + fr, fq * 8), boff = lds_byte(wc * 32 + fr, fq * 8);
#define PG_SA(b, h) (((b) * 2 + (h)) * HTB)
#define PG_SB(b, h) ((4 + (b) * 2 + (h)) * HTB)
#define PG_STAGE(bufoff, gbase, voff) do { _Pragma("unroll") for (int _i = 0; _i < 2; ++_i) \
    __builtin_amdgcn_global_load_lds((const unsigned*)((const char*)(gbase) + (voff)[_i]), (LAS unsigned*)(lds + (bufoff) + ldsw + _i * 8192), 16, 0, 0); } while (0)
#define PG_STAGE_A(bufoff, gbase, raw) do { _Pragma("unroll") for (int _i = 0; _i < 2; ++_i) \
    __builtin_amdgcn_global_load_lds((const unsigned*)((const char*)(gbase) + S.a_off((raw)[_i], c2)), (LAS unsigned*)(lds + (bufoff) + ldsw + _i * 8192), 16, 0, 0); } while (0)
#define PG_LDA(dst, b, h) do { _Pragma("unroll") for (int m = 0; m < 4; ++m) _Pragma("unroll") for (int k = 0; k < 2; ++k) dst[m][k] = *(const LAS bf16x8*)(lds + PG_SA(b, h) + aoff + m * 2048 + k * 1024); } while (0)
#define PG_LDB(dst, b, h) do { _Pragma("unroll") for (int n = 0; n < 2; ++n) _Pragma("unroll") for (int k = 0; k < 2; ++k) dst[n][k] = *(const LAS bf16x8*)(lds + PG_SB(b, h) + boff + n * 2048 + k * 1024); } while (0)
#define PG_MMA(ai, bj, At, Bt) do { __builtin_amdgcn_s_setprio(1); _Pragma("unroll") for (int m = 0; m < 4; ++m) _Pragma("unroll") for (int n = 0; n < 2; ++n) _Pragma("unroll") for (int k = 0; k < 2; ++k) \
    acc[ai][bj][m][n] = __builtin_amdgcn_mfma_f32_16x16x32_bf16(Bt[n][k], At[m][k], acc[ai][bj][m][n], 0, 0, 0); __builtin_amdgcn_s_setprio(0); } while (0)
#define PG_WAIT_V(n) asm volatile("s_waitcnt vmcnt(" #n ")" ::: "memory")
#define PG_WAIT_L(n) asm volatile("s_waitcnt lgkmcnt(" #n ")" ::: "memory")
#define PG_BAR __builtin_amdgcn_s_barrier()
#define PG_SCHED __builtin_amdgcn_sched_barrier(0)
  typename S_t::Unit cur, nxt; int ui = 0;
  if (!S.next(0, cur)) return;
  f32x4 acc[2][2][4][2];
#pragma unroll
  for (int a = 0; a < 2; ++a)
#pragma unroll
    for (int b = 0; b < 2; ++b)
#pragma unroll
      for (int m = 0; m < 4; ++m)
#pragma unroll
        for (int n = 0; n < 2; ++n) acc[a][b][m][n] = (f32x4){0.f, 0.f, 0.f, 0.f};
  bf16x8 At[4][2], B0[2][2], B1[2][2];
  unsigned vA[2][2];
  const char *cA, *cB, *nAb, *nB;
  S.a_ready(cur);
  S.a_src(cur, vA, cA); cB = S.b_src(cur);
  PG_STAGE(PG_SB(0, 0), cB, voffB); PG_STAGE(PG_SB(0, 1), cB + hstep, voffB); PG_STAGE_A(PG_SA(0, 0), cA, vA[0]); PG_STAGE_A(PG_SA(0, 1), cA, vA[1]);
  if (wr == 1) PG_BAR;
  PG_WAIT_V(2); PG_BAR;
  PG_STAGE(PG_SB(1, 0), cB + kstep, voffB); PG_STAGE_A(PG_SA(1, 0), cA + kstep, vA[0]); PG_STAGE(PG_SB(1, 1), cB + hstep + kstep, voffB);
  PG_WAIT_V(6); PG_BAR;
  for (;;) {
    const bool has_next = S.next(ui + 1, nxt);
    nAb = cA; nB = has_next ? S.b_src(nxt) : cB;
    if (has_next) S.a_pre(nxt, tabw, lane);
    for (int t = 0; t < nt; t += 2) {
      const bool last = (t == nt - 2);
      const char* a1 = cA + (size_t)(t + 1) * kstep;
      const char* b2 = last ? nB : cB + (size_t)(t + 2) * kstep;
      const char* b3 = b2 + kstep;
      const char* a2 = last ? nAb : cA + (size_t)(t + 2) * kstep;
      const char* a3 = a2 + kstep;
      if (last && has_next) S.a_ready(nxt);
      PG_LDB(B0, 0, 0); PG_LDB(B1, 0, 1); PG_SCHED; PG_LDA(At, 0, 0); PG_STAGE_A(PG_SA(1, 1), a1, vA[1]);
      if (last && has_next) S.a_late(nxt, vA, tabw, lane);
      PG_WAIT_V(8); PG_WAIT_L(0); PG_BAR; PG_MMA(0, 0, At, B0); PG_MMA(0, 1, At, B1); PG_BAR; PG_SCHED;
      PG_LDA(At, 0, 1); PG_STAGE(PG_SB(0, 0), b2, voffB); PG_STAGE(PG_SB(0, 1), b2 + hstep, voffB); PG_STAGE_A(PG_SA(0, 0), a2, vA[0]);
      PG_WAIT_V(8); PG_WAIT_L(0); PG_BAR; PG_MMA(1, 0, At, B0); PG_MMA(1, 1, At, B1); PG_BAR; PG_SCHED;
      PG_LDB(B0, 1, 0); PG_LDB(B1, 1, 1); PG_SCHED; PG_LDA(At, 1, 0); PG_STAGE_A(PG_SA(0, 1), a2, vA[1]);
      PG_WAIT_V(8); PG_WAIT_L(0); PG_BAR; PG_MMA(0, 0, At, B0); PG_MMA(0, 1, At, B1); PG_BAR; PG_SCHED;
      PG_LDA(At, 1, 1); PG_STAGE(PG_SB(1, 0), b3, voffB); PG_STAGE(PG_SB(1, 1), b3 + hstep, voffB); PG_STAGE_A(PG_SA(1, 0), a3, vA[0]);
      PG_WAIT_V(8); PG_WAIT_L(0); PG_BAR; PG_MMA(1, 0, At, B0); PG_MMA(1, 1, At, B1); PG_BAR; PG_SCHED;
    }
    if (wr == 0) PG_BAR;
    S.epi(acc, cur, wr, wc, fr, fq); S.done(cur);
    if (!has_next) break;
#pragma unroll
    for (int a = 0; a < 2; ++a)
#pragma unroll
      for (int b = 0; b < 2; ++b)
#pragma unroll
        for (int m = 0; m < 4; ++m)
#pragma unroll
          for (int n = 0; n < 2; ++n) acc[a][b][m][n] = (f32x4){0.f, 0.f, 0.f, 0.f};
    cur = nxt; cA = nAb; cB = nB; ++ui;
    if (wr == 1) PG_BAR;
  }
  PG_WAIT_V(0);
  PG_BAR;
#undef PG_SA
#undef PG_SB
#undef PG_STAGE
#undef PG_STAGE_A
#undef PG_LDA
#undef PG_LDB
#undef PG_MMA
#undef PG_WAIT_V
#undef PG_WAIT_L
#undef PG_BAR
#undef PG_SCHED
}
__device__ __forceinline__ void lane_pieces(int (&R)[2], int (&C)[2]) {
#pragma unroll
  for (int i = 0; i < 2; ++i) stage_rc(fresh_tid512() * 16 + i * 8192, R[i], C[i]);
}
}
__device__ __forceinline__ void transpose_item(const float* W, int ldw, int nvalid, int k0, int n0, bf16_t* WT, int gu_map, float* scr, int lane) {
  const int nn = n0 + (lane & 31), ncl = nn < nvalid ? nn : nvalid - 1;
  const float* src = W + (size_t)(k0 + (lane >> 5)) * ldw + ncl;
#pragma unroll 8
  for (int i = 0; i < 32; ++i) scr[(2 * i + (lane >> 5)) * 33 + (lane & 31)] = src[(size_t)(2 * i) * ldw];
  asm volatile("s_waitcnt lgkmcnt(0)" ::: "memory");
  const int c = lane & 7;
#pragma unroll
  for (int j = 0; j < 4; ++j) {
    const int nl = (lane >> 3) + 8 * j, n = n0 + nl;
    const float* s = scr + (8 * c) * 33 + nl;
    uint4 o;
    o.x = pack_bf16(s[0 * 33], s[1 * 33]); o.y = pack_bf16(s[2 * 33], s[3 * 33]);
    o.z = pack_bf16(s[4 * 33], s[5 * 33]); o.w = pack_bf16(s[6 * 33], s[7 * 33]);
    const int row = gu_map ? (256 * (n >> 8) + 128 * (n & 1) + ((n >> 1) & 127)) : n;
    if (n < nvalid) *(uint4*)(WT + (size_t)row * 1024 + k0 + 8 * c) = o;
  }
  asm volatile("s_waitcnt lgkmcnt(0)" ::: "memory");
}
#define TR_I_IN (16 * 71)
#define TR_I_OUT (16 * 32)
#define TR_I_GU (32 * 16 * 64)
#define TR_I_DN (32 * 16 * 32)
__device__ __forceinline__ void phase_transpose(const Params& p, int lo, int hi, int gw, int ngw, float* scr) {
  const int lane = threadIdx.x & 63;
  for (int it = lo + gw; it < hi; it += ngw) {
    int r = it;
    if (r < TR_I_IN) { transpose_item(p.w_in, N_IN, N_IN, 64 * (r / 71), 32 * (r % 71), p.WinT, 0, scr, lane); continue; }
    r -= TR_I_IN;
    if (r < TR_I_OUT) { transpose_item(p.w_out, 1024, 1024, 64 * (r >> 5), 32 * (r & 31), p.WoutT, 0, scr, lane); continue; }
    r -= TR_I_OUT;
    if (r < TR_I_GU) {
      const int e = r >> 10, q = r & 1023;
      transpose_item(p.w_gu + (size_t)e * 1024 * 2048, 2048, 2048, 64 * (q >> 6), 32 * (q & 63), p.WguT + (size_t)e * 2048 * 1024, 1, scr, lane);
      continue;
    }
    r -= TR_I_GU;
    {
      const int e = r >> 9, q = r & 511;
      transpose_item(p.w_dn + (size_t)e * 1024 * 1024, 1024, 1024, 64 * (q >> 5), 32 * (q & 31), p.WdnT + (size_t)e * 1024 * 1024, 0, scr, lane);
    }
  }
}

struct MoeUnit { int e, mt, pn, cnt, gmt; };
__device__ __forceinline__ bool moe_decode(const volatile LAS int* meta, int L, int npn, MoeUnit& u) {
  if (L >= meta[64] * npn) return false;
  const unsigned long long mb = __ballot(L >= meta[33 + (threadIdx.x & 31)] * npn);
  const int e = __popc((unsigned)mb);
  const int cnt = meta[e], tiles = (cnt + 255) >> 8, loc = L - meta[32 + e] * npn;
  const int pn = loc / tiles, mt = loc - pn * tiles;
  u.e = __builtin_amdgcn_readfirstlane(e); u.pn = __builtin_amdgcn_readfirstlane(pn); u.mt = __builtin_amdgcn_readfirstlane(mt);
  u.cnt = __builtin_amdgcn_readfirstlane(cnt); u.gmt = __builtin_amdgcn_readfirstlane(meta[32 + e] + mt);
  return true;
}
struct MoeUp {
  typedef MoeUnit Unit;
  const Params& p; const volatile LAS int* meta; int G, c;
  __device__ __forceinline__ bool next(int i, Unit& u) const { return moe_decode(meta, i * G + c, 8, u); }
  __device__ __forceinline__ void a_src(const Unit& u, unsigned (&vo)[2][2], const char*& base) const {
    int R[2], C[2]; pg::lane_pieces(R, C);
    base = (const char*)p.U2;
    const int* lst = p.lists + u.e * T_TOK;
#pragma unroll
    for (int h = 0; h < 2; ++h)
#pragma unroll
      for (int i = 0; i < 2; ++i) {
        int g = u.mt * 256 + h * 128 + R[i];
        g = g < u.cnt ? g : u.cnt - 1;
        vo[h][i] = (unsigned)lst[g];
      }
  }
  __device__ __forceinline__ void a_pre(const Unit& u, LAS int* tabw, int) const {
    int R[2], C[2]; pg::lane_pieces(R, C);
    const int* lst = p.lists + u.e * T_TOK;
#pragma unroll
    for (int h = 0; h < 2; ++h)
#pragma unroll
      for (int i = 0; i < 2; ++i) {
        int g = u.mt * 256 + h * 128 + R[i];
        g = g < u.cnt ? g : u.cnt - 1;
        __builtin_amdgcn_global_load_lds((const unsigned*)(lst + g), (LAS unsigned*)(tabw + (h * 2 + i) * 64), 4, 0, 0);
      }
  }
  __device__ __forceinline__ void a_late(const Unit&, unsigned (&vo)[2][2], LAS int* tabw, int lane) const {
#pragma unroll
    for (int h = 0; h < 2; ++h)
#pragma unroll
      for (int i = 0; i < 2; ++i) vo[h][i] = (unsigned)tabw[(h * 2 + i) * 64 + lane];
  }
  __device__ __forceinline__ unsigned a_off(unsigned raw, unsigned c2) const {
    unsigned o, t;
    asm volatile("v_bfe_u32 %1, %2, 2, 14\n\tv_lshl_add_u32 %0, %1, 11, %3" : "=v"(o), "=&v"(t) : "v"(raw), "v"(c2));
    return o;
  }
  __device__ __forceinline__ const char* b_src(const Unit& u) const { return (const char*)p.WguT + ((size_t)(u.e * 2048 + u.pn * 256) * 1024) * 2; }
  __device__ __forceinline__ void a_ready(const Unit&) const {}
  __device__ __forceinline__ void epi(const pg::f32x4 (&acc)[2][2][4][2], const Unit& u, int wr, int wc, int fr, int fq) const {
    const int h0 = u.pn * 128 + wc * 32 + fq * 8;
    const float4* bp = (const float4*)(p.b_gu + u.e * 2048 + 2 * h0);
    const float4 f0 = bp[0], f1 = bp[1], f2 = bp[2], f3 = bp[3];
    const float bg[8] = {f0.x, f0.z, f1.x, f1.z, f2.x, f2.z, f3.x, f3.z};
    const float bu[8] = {f0.y, f0.w, f1.y, f1.w, f2.y, f2.w, f3.y, f3.w};
    const __amdgpu_buffer_rsrc_t hrs = make_rsrc(p.Hb);
#pragma unroll
    for (int ai = 0; ai < 2; ++ai)
#pragma unroll
      for (int m = 0; m < 4; ++m) {
        const int r = ai * 128 + wr * 64 + m * 16 + fr;
        float hv[8];
#pragma unroll
        for (int n = 0; n < 2; ++n)
#pragma unroll
          for (int q = 0; q < 4; ++q) {
            const float g = fminf(acc[ai][0][m][n][q] + bg[4 * n + q], 7.f);
            const float uu = fminf(fmaxf(acc[ai][1][m][n][q] + bu[4 * n + q], -7.f), 7.f);
            hv[4 * n + q] = (uu + 1.f) * (g * sigmoidf_(g * 1.702f));
          }
        u32x4_t w;
        w[0] = cvt_pk(hv[0], hv[1]); w[1] = cvt_pk(hv[2], hv[3]); w[2] = cvt_pk(hv[4], hv[5]); w[3] = cvt_pk(hv[6], hv[7]);
        if (u.mt * 256 + r < u.cnt) __builtin_amdgcn_raw_buffer_store_b128(w, hrs, ((u.gmt * 256 + r) * 1024 + h0) * 2, 0, 16);
      }
  }
  __device__ __forceinline__ void done(const Unit& u) const {
    asm volatile("s_waitcnt vmcnt(0)" ::: "memory");
    if ((threadIdx.x & 63) == 0) __hip_atomic_fetch_add(&p.moe_done[u.gmt], 1, __ATOMIC_RELAXED, __HIP_MEMORY_SCOPE_AGENT);
  }
};
struct MoeDn {
  typedef MoeUnit Unit;
  const Params& p; const volatile LAS int* meta; int G, c;
  __device__ __forceinline__ bool next(int i, Unit& u) const { return moe_decode(meta, i * G + c, 4, u); }
  __device__ __forceinline__ void a_src(const Unit& u, unsigned (&vo)[2][2], const char*& base) const {
    int R[2], C[2]; pg::lane_pieces(R, C);
    base = (const char*)p.Hb;
#pragma unroll
    for (int h = 0; h < 2; ++h)
#pragma unroll
      for (int i = 0; i < 2; ++i) vo[h][i] = (unsigned)(u.gmt * 256 + h * 128 + R[i]);
  }
  __device__ __forceinline__ void a_pre(const Unit&, LAS int*, int) const {}
  __device__ __forceinline__ void a_late(const Unit& u, unsigned (&vo)[2][2], LAS int*, int) const { const char* b; a_src(u, vo, b); }
  __device__ __forceinline__ unsigned a_off(unsigned raw, unsigned c2) const {
    unsigned o;
    asm volatile("v_lshl_add_u32 %0, %1, 11, %2" : "=v"(o) : "v"(raw), "v"(c2));
    return o;
  }
  __device__ __forceinline__ const char* b_src(const Unit& u) const { return (const char*)p.WdnT + ((size_t)(u.e * 1024 + u.pn * 256) * 1024) * 2; }
  __device__ __forceinline__ void a_ready(const Unit& u) const {
    if (threadIdx.x < 64) {
      unsigned sp = 0;
      while (__builtin_amdgcn_readfirstlane(__hip_atomic_load(&p.moe_done[u.gmt], __ATOMIC_RELAXED, __HIP_MEMORY_SCOPE_AGENT)) < 64) {
        __builtin_amdgcn_s_sleep(2);
        if (++sp > (1u << 22)) break;
      }
      __builtin_amdgcn_fence(__ATOMIC_ACQUIRE, "agent");
      asm volatile("s_waitcnt vmcnt(0)" ::: "memory");
    }
    asm volatile("" ::: "memory"); __builtin_amdgcn_s_barrier(); asm volatile("" ::: "memory");
  }
  __device__ __forceinline__ void epi(const pg::f32x4 (&acc)[2][2][4][2], const Unit& u, int wr, int wc, int fr, int fq) const {
    const int c0 = u.pn * 256 + wc * 32 + fq * 8;
    const float4* bp = (const float4*)(p.b_dn + u.e * 1024 + c0);
    const float4 b00 = bp[0], b01 = bp[1], b10 = bp[32], b11 = bp[33];
    const int* lst = p.lists + u.e * T_TOK;
    const float* lg = p.lgate + u.e * T_TOK;
    int pr[2][4]; float gt[2][4];
#pragma unroll
    for (int ai = 0; ai < 2; ++ai)
#pragma unroll
      for (int m = 0; m < 4; ++m) {
        int g = u.mt * 256 + ai * 128 + wr * 64 + m * 16 + fr;
        const bool ok = g < u.cnt;
        g = ok ? g : u.cnt - 1;
        pr[ai][m] = ok ? lst[g] : -1;
        gt[ai][m] = lg[g];
      }
#pragma unroll
    for (int ai = 0; ai < 2; ++ai)
#pragma unroll
      for (int m = 0; m < 4; ++m) {
        if (pr[ai][m] >= 0) {
          const float g = gt[ai][m];
          bf16_t* o = p.POb + (size_t)pr[ai][m] * 1024 + c0;
#pragma unroll
          for (int bj = 0; bj < 2; ++bj) {
            const float4 ba = bj ? b10 : b00, bb = bj ? b11 : b01;
            const pg::f32x4 v0 = acc[ai][bj][m][0], v1 = acc[ai][bj][m][1];
            uint4 w;
            w.x = cvt_pk((v0[0] + ba.x) * g, (v0[1] + ba.y) * g); w.y = cvt_pk((v0[2] + ba.z) * g, (v0[3] + ba.w) * g);
            w.z = cvt_pk((v1[0] + bb.x) * g, (v1[1] + bb.y) * g); w.w = cvt_pk((v1[2] + bb.z) * g, (v1[3] + bb.w) * g);
            *(uint4*)(o + bj * 128) = w;
          }
        }
      }
  }
  __device__ __forceinline__ void done(const Unit&) const {}
};
__device__ __forceinline__ void phase_moe8(const Params& p, int c, unsigned char* dl) {
  volatile LAS int* meta = (volatile LAS int*)(dl + MISC_OFF) + 64;
  __syncthreads();
  if (threadIdx.x < 32) meta[threadIdx.x] = p.cnt[threadIdx.x * CNT_STRIDE];
  __syncthreads();
  if (threadIdx.x == 0) {
    int tp = 0;
    for (int e = 0; e < 32; ++e) { meta[32 + e] = tp; tp += (meta[e] + 255) >> 8; }
    meta[64] = tp;
  }
  __syncthreads();
  const MoeUp up{p, meta, (int)gridDim.x, c};
  pg::stream(( LAS unsigned char*)dl, up);
  const MoeDn dn{p, meta, (int)gridDim.x, c};
  pg::stream((LAS unsigned char*)dl, dn);
}

struct DenseUnit { int pm, pn; };
template <int NM, int NN>
__device__ __forceinline__ bool dense_next(int L, DenseUnit& u) {
  if (L >= NM * NN) return false;
  const int nig = 8 * NN, gid = L / nig, l = L - gid * nig;
  u.pm = __builtin_amdgcn_readfirstlane(gid * 8 + (l & 7)); u.pn = __builtin_amdgcn_readfirstlane(l >> 3);
  return true;
}
#define DENSE_COMMON(ABUF, BBUF)                                                                                     \
  typedef DenseUnit Unit;                                                                                            \
  __device__ __forceinline__ void a_src(const Unit& u, unsigned (&vo)[2][2], const char*& base) const {              \
    int R[2], C[2]; pg::lane_pieces(R, C);                                                                           \
    base = (const char*)(ABUF);                                                                                      \
    _Pragma("unroll") for (int h = 0; h < 2; ++h)                                                                    \
      _Pragma("unroll") for (int i = 0; i < 2; ++i) vo[h][i] = (unsigned)(u.pm * 256 + h * 128 + R[i]);              \
  }                                                                                                                  \
  __device__ __forceinline__ void a_pre(const Unit&, LAS int*, int) const {}                                         \
  __device__ __forceinline__ void a_late(const Unit& u, unsigned (&vo)[2][2], LAS int*, int) const { const char* b; a_src(u, vo, b); } \
  __device__ __forceinline__ unsigned a_off(unsigned raw, unsigned c2) const {                                       \
    unsigned o;                                                                                                      \
    asm volatile("v_lshl_add_u32 %0, %1, 11, %2" : "=v"(o) : "v"(raw), "v"(c2));                                     \
    return o;                                                                                                        \
  }                                                                                                                  \
  __device__ __forceinline__ const char* b_src(const Unit& u) const { return (const char*)(BBUF) + (size_t)u.pn * 256 * 1024 * 2; } \
  __device__ __forceinline__ void a_ready(const Unit&) const {}                                                      \
  __device__ __forceinline__ void done(const Unit&) const {}
struct WinP {
  const Params& p; int G, c;
  DENSE_COMMON(p.U1, p.WinT)
  __device__ __forceinline__ bool next(int i, Unit& u) const { return dense_next<64, 9>(i * G + c, u); }
  __device__ __forceinline__ void epi(const pg::f32x4 (&acc)[2][2][4][2], const Unit& u, int wr, int wc, int fr, int fq) const {
    const int c0 = u.pn * 256 + wc * 32 + fq * 8;
#pragma unroll
    for (int ai = 0; ai < 2; ++ai)
#pragma unroll
      for (int m = 0; m < 4; ++m) {
        float* rowp = p.P + (size_t)(u.pm * 256 + ai * 128 + wr * 64 + m * 16 + fr) * N_IN + c0;
#pragma unroll
        for (int bj = 0; bj < 2; ++bj)
#pragma unroll
          for (int n = 0; n < 2; ++n)
            if (c0 + bj * 128 + n * 4 < N_IN) *(pg::f32x4*)(rowp + bj * 128 + n * 4) = acc[ai][bj][m][n];
      }
  }
};
struct OutP {
  const Params& p; int G, c;
  DENSE_COMMON(p.OCATb, p.WoutT)
  __device__ __forceinline__ bool next(int i, Unit& u) const { return dense_next<64, 4>(i * G + c, u); }
  __device__ __forceinline__ void epi(const pg::f32x4 (&acc)[2][2][4][2], const Unit& u, int wr, int wc, int fr, int fq) const {
    const int c0 = u.pn * 256 + wc * 32 + fq * 8;
    const float* gp = p.mod + ((u.pm * 256) >> 11) * 6144 + 2048 + c0;
    pg::f32x4 g[2][2];
#pragma unroll
    for (int bj = 0; bj < 2; ++bj)
#pragma unroll
      for (int n = 0; n < 2; ++n) g[bj][n] = *(const pg::f32x4*)(gp + bj * 128 + n * 4) + 1.0f;
#pragma unroll
    for (int ai = 0; ai < 2; ++ai)
#pragma unroll
      for (int m = 0; m < 4; ++m) {
        const size_t off = (size_t)(u.pm * 256 + ai * 128 + wr * 64 + m * 16 + fr) * 1024 + c0;
#pragma unroll
        for (int bj = 0; bj < 2; ++bj)
#pragma unroll
          for (int n = 0; n < 2; ++n) {
            const pg::f32x4 xv = *(const pg::f32x4*)(p.x + off + bj * 128 + n * 4);
            *(pg::f32x4*)(p.Y1 + off + bj * 128 + n * 4) = xv * ALPHA_RES + g[bj][n] * acc[ai][bj][m][n];
          }
        asm volatile("" ::: "memory");
      }
  }
};

#ifndef SLOT_S
#define SLOT_S 1
#define SLOT_D 3
#endif
__global__ void __launch_bounds__(2 * NTHR, 2) k_mega(Params p) {
  __shared__ __attribute__((aligned(16))) unsigned char dlds[LDS_BYTES];
  volatile LAS unsigned* misc = (volatile LAS unsigned*)(dlds + MISC_OFF);
  if (threadIdx.x < 16) misc[threadIdx.x] = 0u;
  __syncthreads();
  XcdBarrier xb = xcd_barrier_post(p.bar, misc);
  const int half = half_id();
  float* sm = (float*)dlds + half * HALF_FLOATS;
  const int bid = 2 * (int)blockIdx.x + half, nb = 2 * (int)gridDim.x;
  phase_ada(p, bid, nb, sm);
  xcd_barrier(xb);
  phase_u1(p, bid, nb);
  phase_transpose(p, 0, TR_I_IN + TR_I_OUT + TR_I_GU + TR_I_DN, (int)(blockIdx.x * 8 + (threadIdx.x >> 6)), (int)gridDim.x * 8, sm + (fresh_tid() >> 6) * 2112);
  xcd_barrier(xb);
#ifdef PROBE_TR2
  phase_transpose(p, 0, TR_I_IN + TR_I_OUT + TR_I_GU + TR_I_DN, (int)(blockIdx.x * 8 + (threadIdx.x >> 6)), (int)gridDim.x * 8, sm + (fresh_tid() >> 6) * 2112);
  xcd_barrier(xb);
#endif
  const int vblk = xcd_virtual_bid(xb);
  { const WinP wp{p, (int)gridDim.x, vblk}; pg::stream((LAS unsigned char*)dlds, wp); }
  xcd_barrier(xb);
  phase_prep_rwkv(p, bid, nb, sm);
  phase_prep_dsa(p, bid, nb, sm);
  xcd_barrier(xb);
  phase_qproj(p, bid, nb, sm);
  xcd_barrier(xb);
  phase_qabs(p, bid, nb, sm);
  phase_scores(p, bid, nb, sm);
  xcd_barrier(xb);
  {
    const int nscan = (int)gridDim.x;
    const int nslots = (SLOT_S + SLOT_D) * nscan;
    const int slot0 = half == 0 ? SLOT_S * (int)blockIdx.x : SLOT_S * nscan + SLOT_D * (int)blockIdx.x;
    const int nsl = half == 0 ? SLOT_S : SLOT_D;
    if (half == 0) {
      HalfBar hb; hb.cnt = misc + 8; hb.n = 0u;
      __builtin_amdgcn_s_setprio(2);
      for (int item = blockIdx.x; item < 256; item += gridDim.x) scan_item(p, item, sm, hb);
      __builtin_amdgcn_s_setprio(0);
    }
#ifdef BISECT_SPLIT
    (void)slot0; (void)nslots; (void)nsl;
    xcd_barrier(xb);
    phase_topk(p, bid, nb, sm, 1);
    xcd_barrier(xb);
    phase_attn(p, bid, nb, sm, 1);
#else
    phase_topk(p, slot0, nslots, sm, nsl);
    asm volatile("s_waitcnt vmcnt(0)" ::: "memory");
    phase_attn(p, slot0, nslots, sm, nsl);
#endif
  }
  xcd_barrier(xb);
  phase_uv(p, bid, nb, sm);
  phase_rwkv_fin(p, bid, nb, sm);
  xcd_barrier(xb);
  { const OutP op{p, (int)gridDim.x, vblk}; pg::stream((LAS unsigned char*)dlds, op); }
  xcd_barrier(xb);
  phase_ln1_router(p, bid, nb, sm);
  xcd_barrier(xb);
  phase_moe8(p, vblk, dlds);
  xcd_barrier(xb);
#ifdef PROBE_MOE2
  phase_moe8(p, vblk, dlds);
  xcd_barrier(xb);
#endif
  phase_final(p, bid, nb, sm);
}

extern "C" void kernel_launch(void* const* d_in, const int* in_sizes, int n_in, void* d_out, int out_size, void* d_ws,
                              size_t ws_size, hipStream_t stream) {
  Params p{};
  const float** fp = (const float**)&p;
  for (int i = 0; i < 35; ++i) fp[i] = (const float*)d_in[i];
  p.out = (float*)d_out;
  float* w = (float*)d_ws;
  size_t off = 0;
  auto take = [&](size_t n) { float* r = w + off; off += (n + 63) & ~(size_t)63; return r; };
  p.bar = (unsigned*)take(4096);
  p.moe_done = (int*)take(32 * 64);
  p.mod = take(8 * 6144);
  p.X1 = take((size_t)T_TOK * 2);
  p.pgate = take(T_TOK * 4);
  p.lists = (int*)take(32 * T_TOK);
  p.lgate = take(32 * T_TOK);
  p.WinT = (unsigned short*)take((size_t)2304 * 512);
  p.WoutT = (unsigned short*)take((size_t)1024 * 512);
  p.WguT = (unsigned short*)take((size_t)32 * 2048 * 512);
  p.WdnT = (unsigned short*)take((size_t)32 * 1024 * 512);
  p.cnt = (int*)take(32 * 32);
  p.U2 = (unsigned short*)take((size_t)T_TOK * 512);
  const size_t early = off;
  p.P = take((size_t)T_TOK * N_IN);
  p.SC = take((size_t)T_TOK * 8 * 384);
  p.G = take((size_t)T_TOK * 512);
  p.BV = take((size_t)T_TOK * 512);
  p.IW = take((size_t)T_TOK * 8);
  p.QABS = take((size_t)T_TOK * 1024);
  p.SCORES = p.P;
  p.SEL = (int*)take((size_t)T_TOK * 256);
  p.NSEL = (int*)take(T_TOK);
  p.ORAW = take((size_t)T_TOK * 512);
  p.U1 = (unsigned short*)take((size_t)T_TOK * 512);
  p.QLATb = (unsigned short*)take((size_t)T_TOK * 128);
  p.Qb = (unsigned short*)take((size_t)T_TOK * 256);
  p.IQb = (unsigned short*)take((size_t)T_TOK * 256);
  p.IKb = (unsigned short*)take((size_t)T_TOK * 32);
  p.OCATb = (unsigned short*)take((size_t)T_TOK * 512);
  p.OLATb = (unsigned short*)take((size_t)T_TOK * 512);
  p.QABSb = (unsigned short*)take((size_t)T_TOK * 512);
  p.CLATb = (unsigned short*)take((size_t)T_TOK * 64);
  p.Y1 = p.QABS;
  p.Hb = (unsigned short*)(w + early);
  p.POb = p.Hb + (size_t)(T_TOK * 4 + 32 * 256) * 1024;
  static int grid_blocks = 0;
  if (!grid_blocks) {
    int dev = 0, cus = 0, per_cu = 0;
    (void)hipGetDevice(&dev);
    (void)hipDeviceGetAttribute(&cus, hipDeviceAttributeMultiprocessorCount, dev);
    (void)hipOccupancyMaxActiveBlocksPerMultiprocessor(&per_cu, k_mega, 2 * NTHR, 0);
    if (per_cu > 1) per_cu = 1;
    if (per_cu < 1) per_cu = 1;
    grid_blocks = cus * per_cu;
  }
  (void)hipMemsetAsync(p.bar, 0, XCD_BAR_WORDS * sizeof(unsigned), stream);
  void* args[] = {&p};
  (void)hipLaunchCooperativeKernel((void*)k_mega, dim3(grid_blocks), dim3(2 * NTHR), args, 0, stream);
}
```
